# Optimizing an MI355X kernel written in HIP

```python
import math
import jax, jax.numpy as jnp
from jax import lax
import numpy as np

D_MODEL = 1024
BATCH = 4
SEQ = 4096
DEPTH = 4

CHUNK = 64
N_EVEN = (DEPTH + 1) // 2
N_ODD = DEPTH // 2
EPS = 1e-6
GDN_HEAD_DIM = 128
GDN_WIDTH = D_MODEL // 2
GDN_HEADS = GDN_WIDTH // GDN_HEAD_DIM
CONV_K = 4
S5_WIDTH = D_MODEL - GDN_WIDTH
S5_GROUP = 16
S5_GROUPS = S5_WIDTH // S5_GROUP
S5_STATE = 64
EVEN_IN = 4 * GDN_WIDTH + 2 * GDN_HEADS + S5_WIDTH
DIFF_HEAD_DIM = 64
DIFF_HEADS = D_MODEL // (2 * DIFF_HEAD_DIM)
DIFF_WIDTH = DIFF_HEADS * 2 * DIFF_HEAD_DIM
Q_BLOCK = 128
D_FF = ((8 * D_MODEL // 3 + 127) // 128) * 128
N_EXPERTS = 8
TOP_K = 2

kernel_name = 'hybrid_gdn_s5_diffattn_moe_adaln'


def rmsnorm(x, w):
    x32 = x.astype(jnp.float32)
    y = x32 * lax.rsqrt(jnp.mean(x32 * x32, axis=-1, keepdims=True) + EPS)
    return (y * w.astype(jnp.float32)).astype(x.dtype)


def l2norm(x):
    return x * lax.rsqrt(jnp.sum(x * x, axis=-1, keepdims=True) + EPS)


def causal_conv(x, w):
    k = w.shape[0]
    return lax.conv_general_dilated(x, w[:, None, :].astype(x.dtype), window_strides=(1,), padding=[(k - 1, 0)], dimension_numbers=('NWC', 'WIO', 'NWC'), feature_group_count=w.shape[1])


def to_chunks(t):
    bn, seq, nh, d = t.shape
    return t.reshape(bn, seq // CHUNK, CHUNK, nh, d).transpose(1, 0, 3, 2, 4)


def gated_delta_rule(q, k, v, g, beta):
    bn, seq, nh, dk = q.shape
    dv = v.shape[-1]
    q, k, v = to_chunks(q), to_chunks(k), to_chunks(v)
    g = jnp.cumsum(to_chunks(g[..., None])[..., 0], axis=-1)
    beta = to_chunks(beta[..., None])[..., 0]
    idx = jnp.arange(CHUNK)
    causal = idx[:, None] >= idx[None, :]
    strict = idx[:, None] > idx[None, :]
    decay = jnp.exp(jnp.where(causal, g[..., :, None] - g[..., None, :], -jnp.inf))
    k_beta = k * beta[..., None]
    m = jnp.where(strict, jnp.einsum('nbhid,nbhjd->nbhij', k_beta, k) * decay, 0.0)
    rhs = jnp.concatenate([v * beta[..., None], k_beta * jnp.exp(g)[..., None]], axis=-1)
    sol = lax.linalg.triangular_solve(jnp.eye(CHUNK, dtype=m.dtype) + m, rhs, left_side=True, lower=True)
    u, w = sol[..., :dv], sol[..., dv:]
    qk = jnp.where(causal, jnp.einsum('nbhid,nbhjd->nbhij', q, k) * decay, 0.0)

    def step(state, inp):
        q_c, k_c, u_c, w_c, g_c, qk_c = inp
        v_new = u_c - jnp.einsum('bhcd,bhde->bhce', w_c, state)
        o_c = jnp.einsum('bhcd,bhde->bhce', q_c * jnp.exp(g_c)[..., None], state) + jnp.einsum('bhij,bhje->bhie', qk_c, v_new)
        g_last = g_c[..., -1:]
        state = state * jnp.exp(g_last)[..., None] + jnp.einsum('bhcd,bhce->bhde', k_c * jnp.exp(g_last - g_c)[..., None], v_new)
        return state, o_c

    state0 = jnp.zeros((bn, nh, dk, dv), jnp.float32)
    _, o = lax.scan(step, state0, (q, k, u, w, g, qk))
    return o.transpose(1, 0, 3, 2, 4).reshape(bn, seq, nh, dv)


def s5_glu(u, lam_re, lam_im, log_step, b_re, b_im, c_re, c_im, d_skip, glu_w, glu_b):
    bn, seq, _ = u.shape
    f32 = jnp.float32
    u32 = u.astype(f32).reshape(bn, seq, S5_GROUPS, S5_GROUP)
    lr = jnp.minimum(lam_re.astype(f32), -1e-4)
    li = lam_im.astype(f32)
    dt = jnp.exp(log_step.astype(f32))[:, None]
    mag = jnp.exp(lr * dt)
    ar, ai = mag * jnp.cos(li * dt), mag * jnp.sin(li * dt)
    nr, ni = ar - 1.0, ai
    den = lr * lr + li * li
    cr, ci = (nr * lr + ni * li) / den, (ni * lr - nr * li) / den
    b_re, b_im = b_re.astype(f32), b_im.astype(f32)
    bbr = cr[..., None] * b_re - ci[..., None] * b_im
    bbi = cr[..., None] * b_im + ci[..., None] * b_re
    bu_r = jnp.einsum('gnc,blgc->blgn', bbr, u32)
    bu_i = jnp.einsum('gnc,blgc->blgn', bbi, u32)
    a_r = jnp.broadcast_to(ar, bu_r.shape)
    a_i = jnp.broadcast_to(ai, bu_r.shape)

    def combine(e1, e2):
        a1r, a1i, b1r, b1i = e1
        a2r, a2i, b2r, b2i = e2
        return (a2r * a1r - a2i * a1i, a2r * a1i + a2i * a1r, a2r * b1r - a2i * b1i + b2r, a2r * b1i + a2i * b1r + b2i)

    _, _, xr, xi = lax.associative_scan(combine, (a_r, a_i, bu_r, bu_i), axis=1)
    y = (jnp.einsum('gcn,blgn->blgc', c_re.astype(f32), xr) - jnp.einsum('gcn,blgn->blgc', c_im.astype(f32), xi)
         + d_skip.astype(f32).reshape(S5_GROUPS, S5_GROUP) * u32)
    y = jax.nn.gelu(y.reshape(bn, seq, S5_WIDTH), approximate=False)
    ga, gb = jnp.split(y @ glu_w.astype(f32) + glu_b.astype(f32), 2, axis=-1)
    return (ga * jax.nn.sigmoid(gb)).astype(u.dtype)


def hybrid_mixer(h, w_in, conv_w, a_log, dt_bias, gdn_norm_w, lam_re, lam_im, log_step, b_re, b_im, c_re, c_im, d_skip, glu_w, glu_b, w_out):
    bn, seq, _ = h.shape
    f32 = jnp.float32
    proj = h @ w_in
    qkv, z, b, a, u = jnp.split(proj, [3 * GDN_WIDTH, 4 * GDN_WIDTH, 4 * GDN_WIDTH + GDN_HEADS, 4 * GDN_WIDTH + 2 * GDN_HEADS], axis=-1)
    qkv = jax.nn.silu(causal_conv(qkv, conv_w)).astype(f32)
    q, k, v = (t.reshape(bn, seq, GDN_HEADS, GDN_HEAD_DIM) for t in jnp.split(qkv, 3, axis=-1))
    beta = jax.nn.sigmoid(b.astype(f32))
    g = -jnp.exp(a_log.astype(f32)) * jax.nn.softplus(a.astype(f32) + dt_bias.astype(f32))
    o = gated_delta_rule(l2norm(q) * GDN_HEAD_DIM ** -0.5, l2norm(k), v, g, beta)
    o = rmsnorm(o, gdn_norm_w) * jax.nn.silu(z.astype(f32).reshape(bn, seq, GDN_HEADS, GDN_HEAD_DIM))
    y_a = o.reshape(bn, seq, GDN_WIDTH).astype(h.dtype)
    y_b = s5_glu(u, lam_re, lam_im, log_step, b_re, b_im, c_re, c_im, d_skip, glu_w, glu_b)
    return jnp.concatenate([y_a, y_b], axis=-1) @ w_out


def diff_attention(h, w_qkv, q_norm_w, k_norm_w, lq1, lk1, lq2, lk2, subln_w, w_out, lambda_init):
    bn, seq, _ = h.shape
    f32 = jnp.float32
    q, k, v = jnp.split(h @ w_qkv, 3, axis=-1)
    q = rmsnorm(q.reshape(bn, seq, DIFF_HEADS, 2, DIFF_HEAD_DIM), q_norm_w).astype(f32) * DIFF_HEAD_DIM ** -0.5
    k = rmsnorm(k.reshape(bn, seq, DIFF_HEADS, 2, DIFF_HEAD_DIM), k_norm_w).astype(f32)
    v = v.reshape(bn, seq, DIFF_HEADS, 2 * DIFF_HEAD_DIM).astype(f32)
    lam = (jnp.exp(jnp.sum(lq1.astype(f32) * lk1.astype(f32))) - jnp.exp(jnp.sum(lq2.astype(f32) * lk2.astype(f32))) + lambda_init)
    n_blk = seq // Q_BLOCK
    qb = q.reshape(bn, n_blk, Q_BLOCK, DIFF_HEADS, 2, DIFF_HEAD_DIM).transpose(1, 0, 2, 3, 4, 5)
    key_chunk = jnp.arange(seq) // CHUNK

    def block(args):
        q_blk, blk = args
        q_chunk = (blk * Q_BLOCK + jnp.arange(Q_BLOCK)) // CHUNK
        allowed = key_chunk[None, :] <= q_chunk[:, None]
        s = jnp.einsum('bqhtd,bkhtd->bhtqk', q_blk, k)
        p = jax.nn.softmax(jnp.where(allowed, s, -jnp.inf), axis=-1)
        p = p[:, :, 0] - lam * p[:, :, 1]
        return jnp.einsum('bhqk,bkhe->bqhe', p, v)

    o = lax.map(block, (qb, jnp.arange(n_blk)))
    o = o.transpose(1, 0, 2, 3, 4).reshape(bn, seq, DIFF_HEADS, 2 * DIFF_HEAD_DIM)
    o = rmsnorm(o, subln_w) * (1.0 - lambda_init)
    return o.reshape(bn, seq, DIFF_WIDTH).astype(h.dtype) @ w_out


def swiglu(h, w13, w2):
    a, b = jnp.split(h @ w13, 2, axis=-1)
    return (jax.nn.silu(a) * b) @ w2


def moe_swiglu(h, router_w, w13, w2):
    logits = (h @ router_w).astype(jnp.float32)
    top_v, top_i = lax.top_k(logits, TOP_K)
    gates = jax.nn.softmax(top_v, axis=-1)
    combine = jnp.sum(jax.nn.one_hot(top_i, N_EXPERTS, dtype=jnp.float32) * gates[..., None], axis=-2)
    out = jnp.zeros(h.shape, h.dtype)
    for e in range(N_EXPERTS):
        out = out + combine[..., e:e + 1].astype(h.dtype) * swiglu(h, w13[e], w2[e])
    return out


def setup_inputs(seed: int = 0) -> dict:
    key = jax.random.key(seed)
    keys = iter(jax.random.split(key, 64))
    f32 = jnp.float32
    D, F, NE, NO = D_MODEL, D_FF, N_EVEN, N_ODD

    def nrm(shape, scale):
        return jax.random.normal(next(keys), shape, f32) * scale

    def gain(shape):
        return 1.0 + nrm(shape, 0.01)

    def log_uniform(shape, lo, hi):
        return jax.random.uniform(next(keys), shape, f32, minval=math.log(lo), maxval=math.log(hi))

    dt = jnp.exp(log_uniform((NE, GDN_HEADS), 1e-3, 1e-1))
    return {
        'x': nrm((BATCH, SEQ, D), 1.0),
        'c': nrm((BATCH, D), 1.0),
        'ada_w': nrm((DEPTH, D, 6 * D), 0.5 * D ** -0.5),
        'ada_b': nrm((DEPTH, 6 * D), 0.01),
        'norm_mix_w': gain((DEPTH, D)),
        'norm_ffn_w': gain((DEPTH, D)),
        'even_w_in': nrm((NE, D, EVEN_IN), D ** -0.5),
        'even_conv_w': nrm((NE, CONV_K, 3 * GDN_WIDTH), CONV_K ** -0.5),
        'even_a_log': jnp.log(jax.random.uniform(next(keys), (NE, GDN_HEADS), f32, minval=1.0, maxval=16.0)),
        'even_dt_bias': dt + jnp.log(-jnp.expm1(-dt)),
        'even_gdn_norm_w': gain((NE, GDN_HEAD_DIM)),
        'even_lam_re': -0.5 + nrm((NE, S5_GROUPS, S5_STATE), 0.01),
        'even_lam_im': math.pi * jnp.arange(S5_STATE, dtype=f32) + nrm((NE, S5_GROUPS, S5_STATE), 0.01),
        'even_log_step': log_uniform((NE, S5_GROUPS), 1e-3, 1e-1),
        'even_b_re': nrm((NE, S5_GROUPS, S5_STATE, S5_GROUP), (2 * S5_GROUP) ** -0.5),
        'even_b_im': nrm((NE, S5_GROUPS, S5_STATE, S5_GROUP), (2 * S5_GROUP) ** -0.5),
        'even_c_re': nrm((NE, S5_GROUPS, S5_GROUP, S5_STATE), S5_STATE ** -0.5),
        'even_c_im': nrm((NE, S5_GROUPS, S5_GROUP, S5_STATE), S5_STATE ** -0.5),
        'even_d_skip': nrm((NE, S5_WIDTH), 1.0),
        'even_glu_w': nrm((NE, S5_WIDTH, 2 * S5_WIDTH), S5_WIDTH ** -0.5),
        'even_glu_b': nrm((NE, 2 * S5_WIDTH), 0.01),
        'even_w_out': nrm((NE, GDN_WIDTH + S5_WIDTH, D), (GDN_WIDTH + S5_WIDTH) ** -0.5),
        'even_ffn_w13': nrm((NE, D, 2 * F), D ** -0.5),
        'even_ffn_w2': nrm((NE, F, D), F ** -0.5),
        'odd_w_qkv': nrm((NO, D, 3 * DIFF_WIDTH), D ** -0.5),
        'odd_q_norm_w': gain((NO, DIFF_HEAD_DIM)),
        'odd_k_norm_w': gain((NO, DIFF_HEAD_DIM)),
        'odd_lambda_q1': nrm((NO, DIFF_HEAD_DIM), 0.1),
        'odd_lambda_k1': nrm((NO, DIFF_HEAD_DIM), 0.1),
        'odd_lambda_q2': nrm((NO, DIFF_HEAD_DIM), 0.1),
        'odd_lambda_k2': nrm((NO, DIFF_HEAD_DIM), 0.1),
        'odd_subln_w': gain((NO, 2 * DIFF_HEAD_DIM)),
        'odd_w_out': nrm((NO, DIFF_WIDTH, D), DIFF_WIDTH ** -0.5),
        'odd_router_w': nrm((NO, D, N_EXPERTS), D ** -0.5),
        'odd_expert_w13': nrm((NO, N_EXPERTS, D, 2 * F), D ** -0.5),
        'odd_expert_w2': nrm((NO, N_EXPERTS, F, D), F ** -0.5),
    }


def reference(x, c, ada_w, ada_b, norm_mix_w, norm_ffn_w,
              even_w_in, even_conv_w, even_a_log, even_dt_bias, even_gdn_norm_w,
              even_lam_re, even_lam_im, even_log_step, even_b_re, even_b_im, even_c_re, even_c_im,
              even_d_skip, even_glu_w, even_glu_b, even_w_out, even_ffn_w13, even_ffn_w2,
              odd_w_qkv, odd_q_norm_w, odd_k_norm_w, odd_lambda_q1, odd_lambda_k1, odd_lambda_q2, odd_lambda_k2,
              odd_subln_w, odd_w_out, odd_router_w, odd_expert_w13, odd_expert_w2):
    cond = jax.nn.silu(c)
    for layer in range(DEPTH):
        i = layer // 2
        mod = (cond @ ada_w[layer] + ada_b[layer])[:, None, :].astype(x.dtype)
        sh1, sc1, g1, sh2, sc2, g2 = jnp.split(mod, 6, axis=-1)
        h = rmsnorm(x, norm_mix_w[layer]) * (1.0 + sc1) + sh1
        if layer % 2 == 0:
            y = hybrid_mixer(h, even_w_in[i], even_conv_w[i], even_a_log[i], even_dt_bias[i], even_gdn_norm_w[i],
                             even_lam_re[i], even_lam_im[i], even_log_step[i], even_b_re[i], even_b_im[i],
                             even_c_re[i], even_c_im[i], even_d_skip[i], even_glu_w[i], even_glu_b[i], even_w_out[i])
        else:
            lambda_init = 0.8 - 0.6 * math.exp(-0.3 * layer)
            y = diff_attention(h, odd_w_qkv[i], odd_q_norm_w[i], odd_k_norm_w[i], odd_lambda_q1[i], odd_lambda_k1[i],
                               odd_lambda_q2[i], odd_lambda_k2[i], odd_subln_w[i], odd_w_out[i], lambda_init)
        x = x + g1 * y
        h = rmsnorm(x, norm_ffn_w[layer]) * (1.0 + sc2) + sh2
        if layer % 2 == 0:
            f = swiglu(h, even_ffn_w13[i], even_ffn_w2[i])
        else:
            f = moe_swiglu(h, odd_router_w[i], odd_expert_w13[i], odd_expert_w2[i])
        x = x + g2 * f
    return x
```

```cpp
#include <hip/hip_runtime.h>
#include <cstdio>
#include <cstring>
#include <cstdint>

#define LAS __attribute__((address_space(3)))
#define DI __device__ __forceinline__
typedef unsigned short bf16_t;
typedef short bf16x8 __attribute__((ext_vector_type(8)));
typedef short s16x4 __attribute__((ext_vector_type(4)));
typedef float f32x2 __attribute__((ext_vector_type(2)));
typedef float f32x4 __attribute__((ext_vector_type(4)));
typedef float f32x16 __attribute__((ext_vector_type(16)));
typedef unsigned u32x2 __attribute__((ext_vector_type(2)));
typedef unsigned u32x4 __attribute__((ext_vector_type(4)));
typedef __bf16 bf16x2_t __attribute__((ext_vector_type(2)));

DI unsigned pk2(float a, float b) { f32x2 v = {a, b}; bf16x2_t r = __builtin_convertvector(v, bf16x2_t); return __builtin_bit_cast(unsigned, r); }
DI bf16_t f2bf(float a) { return (bf16_t)(pk2(a, 0.f) & 0xffffu); }
DI float bf2f(bf16_t v) { return __uint_as_float(((unsigned)v) << 16); }
DI float bflo(unsigned w) { return __uint_as_float(w << 16); }
DI float bfhi(unsigned w) { return __uint_as_float(w & 0xffff0000u); }
#define dpp_f(v, ctrl) __builtin_bit_cast(float, __builtin_amdgcn_update_dpp(0, __builtin_bit_cast(int, (float)(v)), (ctrl), 0xf, 0xf, true))
#define DPP_QP1032 0xB1
#define DPP_QP2301 0x4E
#define DPP_ROW_HALF_MIRROR 0x141
#define DPP_ROW_MIRROR 0x140
DI float row16_sum(float v) { v += dpp_f(v, DPP_QP1032); v += dpp_f(v, DPP_QP2301); v += dpp_f(v, DPP_ROW_HALF_MIRROR); v += dpp_f(v, DPP_ROW_MIRROR); return v; }
DI float wave_sum(float v) { v = row16_sum(v); v += __shfl_xor(v, 16); v += __shfl_xor(v, 32); return v; }
DI float wave_max(float v) {
#pragma unroll
    for (int o = 1; o < 64; o <<= 1) v = fmaxf(v, __shfl_xor(v, o));
    return v;
}
DI float silu_f(float a) { return a * __builtin_amdgcn_rcpf(1.0f + __expf(-a)); }
DI float sigmoid_f(float a) { return __builtin_amdgcn_rcpf(1.0f + __expf(-a)); }

#define XB_TMO      128
#define XB_XCNT(j)  (256  + 64 * (j))
#define XB_XSUB(j)  (1280 + 64 * (j))
#define XB_XGEN(j)  (2304 + 64 * (j))
#define XB_TOP      3328
#define XB_TOPGEN   3392
#define XCD_BAR_WORDS 3456
#define XB_SPIN_CAP (1u << 22)

__device__ __forceinline__ unsigned xb_ld(unsigned* p)              { return __hip_atomic_load(p, __ATOMIC_RELAXED, __HIP_MEMORY_SCOPE_AGENT); }
__device__ __forceinline__ unsigned xb_add(unsigned* p, unsigned v) { return __hip_atomic_fetch_add(p, v, __ATOMIC_RELAXED, __HIP_MEMORY_SCOPE_AGENT); }
__device__ __forceinline__ unsigned xb_xcc_id() { return (unsigned)__builtin_amdgcn_s_getreg((3 << 11) | 20) & 0xFu; }
#define XB_SPIN(cond, bar) do { unsigned _sp = 0; while (cond) { __builtin_amdgcn_s_sleep(1); \
    if ((++_sp & 255u) == 0u) { if (xb_ld(&(bar)[XB_TMO])) break; if (_sp > XB_SPIN_CAP) { atomicAdd(&(bar)[XB_TMO], 1u); break; } } } } while (0)

struct XcdBarrier { unsigned* bar; unsigned x; volatile LAS unsigned* st; };

__device__ __forceinline__ XcdBarrier xcd_barrier_post(unsigned* bar, volatile LAS unsigned* st) {
    XcdBarrier b; b.bar = bar; b.x = xb_xcc_id(); b.st = st;
    if (threadIdx.x == 0) (void)xb_add(&bar[XB_XCNT(b.x)], 1u);
    return b;
}
__device__ __forceinline__ void xcd_barrier_complete(unsigned* bar, unsigned x, unsigned& nloc, unsigned& nx) {
    const unsigned G = gridDim.x * gridDim.y * gridDim.z;
    unsigned sum, cnt, mine, sp = 0u;
    for (;;) {
        sum = 0u; cnt = 0u; mine = 0u;
#pragma unroll
        for (unsigned j = 0; j < 16; ++j) { const unsigned c = xb_ld(&bar[XB_XCNT(j)]); sum += c; cnt += (c > 0u) ? 1u : 0u; mine = (j == x) ? c : mine; }
        if (sum == G) break;
        __builtin_amdgcn_s_sleep(1);
        if ((++sp & 255u) == 0u) { if (xb_ld(&bar[XB_TMO])) break; if (sp > XB_SPIN_CAP) { atomicAdd(&bar[XB_TMO], 1u); break; } }
    }
    nloc = mine > 0u ? mine : 1u; nx = cnt > 0u ? cnt : 1u;
}
__device__ __forceinline__ void xcd_barrier(const XcdBarrier& b) {
    asm volatile("s_waitcnt vmcnt(0)" ::: "memory");
    __syncthreads();
    if (threadIdx.x == 0) {
        unsigned* bar = b.bar;
        __builtin_amdgcn_s_waitcnt(0);
        unsigned nloc = b.st[0], nx = b.st[1];
        if (nloc == 0u) { xcd_barrier_complete(bar, b.x, nloc, nx); b.st[0] = nloc; b.st[1] = nx; }
        const unsigned old = xb_add(&bar[XB_XSUB(b.x)], 1u);
        const unsigned gen = old / nloc;
        if (old + 1u == (gen + 1u) * nloc) {
            __builtin_amdgcn_fence(__ATOMIC_RELEASE, "agent");
            asm volatile("s_waitcnt vmcnt(0)" ::: "memory");
            const unsigned og = xb_add(&bar[XB_TOP], 1u);
            const unsigned tg = og / nx;
            if (og + 1u == (tg + 1u) * nx) xb_add(&bar[XB_TOPGEN], 1u);
            else XB_SPIN(xb_ld(&bar[XB_TOPGEN]) == tg, bar);
            __builtin_amdgcn_fence(__ATOMIC_ACQUIRE, "agent");
            xb_add(&bar[XB_XGEN(b.x)], 1u);
            asm volatile("s_waitcnt vmcnt(0)" ::: "memory");
        } else {
            XB_SPIN(xb_ld(&bar[XB_XGEN(b.x)]) == gen, bar);
            __builtin_amdgcn_fence(__ATOMIC_ACQUIRE, "agent");
            asm volatile("s_waitcnt vmcnt(0)" ::: "memory");
        }
    }
    __syncthreads();
}

namespace pg8 {
constexpr int BM = 256, BK = 64, HALF = 128, HTB = HALF * BK * 2, STAGE_BYTES = 8 * HTB, NXCD = 8, WGM = 4;
__host__ __device__ __forceinline__ int lds_byte(int r, int c) { const int st = (r >> 4) * 2 + (c >> 5), rr = r & 15, cc = c & 31, ob = rr * 64 + cc * 2; return st * 1024 + (ob ^ (((ob >> 9) & 1) << 5)); }
__host__ __device__ __forceinline__ void stage_rc(int b, int& R, int& C) { const int st = b / 1024, sb = b % 1024, swz = sb ^ (((sb >> 9) & 1) << 5); R = (st >> 1) * 16 + swz / 64; C = (st & 1) * 32 + (swz % 64) / 2; }
__host__ __device__ __forceinline__ int perm32(int rho) { const int n = rho >> 4, i = rho & 15; return 8 * (i >> 2) + 4 * n + (i & 3); }

struct Unit { int pm, pn, pb, pa; };
struct Gemm { const bf16_t* A; const bf16_t* Bt; int M, N, K; };

struct StaticOrder {
    int nM, nN, nwg, G, c;
    __device__ void init(int M, int N, int G_, int c_) { nM = M / BM; nN = N / BM; nwg = nM * nN; G = G_; c = c_; }
    __device__ bool next(int i, Unit& u) const {
        const long L = (long)i * G + c; if (L >= nwg) return false;
        int wgid = (int)L; { const int q = nwg / NXCD, r = nwg % NXCD, xcd = wgid % NXCD, off = wgid / NXCD; wgid = (xcd < r ? xcd * (q + 1) : r * (q + 1) + (xcd - r) * q) + off; }
        const int nig = WGM * nN, gid = wgid / nig, fm = gid * WGM, gsz = (nM - fm) < WGM ? (nM - fm) : WGM;
        u.pm = fm + ((wgid % nig) % gsz); u.pn = (wgid % nig) / gsz; u.pb = u.pn; u.pa = u.pm; return true;
    }
};
struct GroupedOrder {
    int toff[9]; int nN, G, c, a_sparse;
    __device__ void init(const unsigned* cnt, int nN_, int G_, int c_, int a_sparse_) {
        int acc = 0;
#pragma unroll
        for (int e = 0; e < 8; ++e) { toff[e] = acc; acc += ((int)__hip_atomic_load(cnt + 64 * e, __ATOMIC_RELAXED, __HIP_MEMORY_SCOPE_AGENT) + 255) >> 8; }
        toff[8] = acc; nN = nN_; G = G_; c = c_; a_sparse = a_sparse_;
    }
    __device__ bool next(int i, Unit& u) const {
        const long L = (long)i * G + c; const int nwg = toff[8] * nN; if (L >= (long)nwg) return false;
        int wgid = (int)L; { const int q = nwg / NXCD, r = nwg % NXCD, xcd = wgid % NXCD, off = wgid / NXCD; wgid = (xcd < r ? xcd * (q + 1) : r * (q + 1) + (xcd - r) * q) + off; }
        const int nig = WGM * nN, gid = wgid / nig, fm = gid * WGM, gsz = (toff[8] - fm) < WGM ? (toff[8] - fm) : WGM;
        const int rt = fm + ((wgid % nig) % gsz), pn = (wgid % nig) / gsz; int e = 0;
#pragma unroll
        for (int q = 1; q < 8; ++q) e += (rt >= toff[q]) ? 1 : 0;
        int te = 0;
#pragma unroll
        for (int q = 0; q < 8; ++q) te = (q == e) ? toff[q] : te;
        u.pm = rt; u.pn = pn; u.pb = e * nN + pn; u.pa = a_sparse ? (e * 64 + (rt - te)) : rt; return true;
    }
};

template <class Epi, class Sched, bool ALIGN_EPI = true, bool SP2 = true>
__device__ __forceinline__ void gemm_phase(LAS unsigned char* lds, const int tid, const Gemm g, const Sched& S, const Epi& E) {
    const int wid = __builtin_amdgcn_readfirstlane(tid >> 6), lane = tid & 63, wr = wid >> 2, wc = wid & 3, fr = lane & 15, fq = lane >> 4;
    const int K = g.K, nt = K / BK;
    unsigned voffA[2], voffB[2];
#pragma unroll
    for (int i = 0; i < 2; ++i) { int R, C; stage_rc(tid * 16 + i * 8192, R, C); const int Rb = Epi::PERM ? ((R & ~31) + perm32(R & 31)) : R;
        voffA[i] = (unsigned)(R * K + C) * 2u; voffB[i] = (unsigned)(Rb * K + C) * 2u; }
    const size_t kstep = (size_t)(BK * 2);
    const size_t hstep = (size_t)HALF * K * 2;
    const size_t tstep = 2 * hstep;
    const unsigned ldsw = (unsigned)wid * 1024u;
    const int aoff = lds_byte(wr * 64 + fr, fq * 8), boff = lds_byte(wc * 32 + fr, fq * 8);
#define PG8_SA(b, h) (((b) * 2 + (h)) * HTB)
#define PG8_SB(b, h) ((4 + (b) * 2 + (h)) * HTB)
#define PG8_STAGE(bufoff, gbase, voff) do { _Pragma("unroll") for (int _i = 0; _i < 2; ++_i) \
        __builtin_amdgcn_global_load_lds((const unsigned*)((const char*)(gbase) + (voff)[_i]), (LAS unsigned*)(lds + (bufoff) + ldsw + _i * 8192), 16, 0, 0); } while (0)
#define PG8_LDA(dst, b, h) do { _Pragma("unroll") for (int m = 0; m < 4; ++m) _Pragma("unroll") for (int k = 0; k < 2; ++k) dst[m][k] = *(const LAS bf16x8*)(lds + PG8_SA(b, h) + aoff + m * 2048 + k * 1024); } while (0)
#define PG8_LDB(dst, b, h) do { _Pragma("unroll") for (int n = 0; n < 2; ++n) _Pragma("unroll") for (int k = 0; k < 2; ++k) dst[n][k] = *(const LAS bf16x8*)(lds + PG8_SB(b, h) + boff + n * 2048 + k * 1024); } while (0)
#define PG8_MMA(ai, bj, At, Bt) do { __builtin_amdgcn_s_setprio(1); _Pragma("unroll") for (int m = 0; m < 4; ++m) _Pragma("unroll") for (int n = 0; n < 2; ++n) _Pragma("unroll") for (int k = 0; k < 2; ++k) \
        acc[ai][bj][m][n] = __builtin_amdgcn_mfma_f32_16x16x32_bf16(Bt[n][k], At[m][k], acc[ai][bj][m][n], 0, 0, 0); __builtin_amdgcn_s_setprio(0); } while (0)
#define PG8_WAIT_V(n) asm volatile("s_waitcnt vmcnt(" #n ")" ::: "memory")
#define PG8_WAIT_L(n) asm volatile("s_waitcnt lgkmcnt(" #n ")" ::: "memory")
#define PG8_BAR __builtin_amdgcn_s_barrier()
#define PG8_SCHED __builtin_amdgcn_sched_barrier(0)
    Unit cur, nxt; int ui = 0;
    if (!S.next(0, cur)) return;
    f32x4 acc[2][2][4][2];
#pragma unroll
    for (int a = 0; a < 2; ++a)
#pragma unroll
        for (int b = 0; b < 2; ++b)
#pragma unroll
            for (int m = 0; m < 4; ++m)
#pragma unroll
                for (int n = 0; n < 2; ++n) acc[a][b][m][n] = (f32x4){0.f, 0.f, 0.f, 0.f};
    bf16x8 At[4][2], B0[2][2], B1[2][2];
    const char* cA = (const char*)g.A + (size_t)cur.pa * tstep; const char* cB = (const char*)g.Bt + (size_t)cur.pb * tstep;
    if constexpr (SP2) {
        PG8_STAGE(PG8_SB(0, 0), cB, voffB); PG8_STAGE(PG8_SB(0, 1), cB + hstep, voffB); PG8_STAGE(PG8_SA(0, 0), cA, voffA); PG8_STAGE(PG8_SA(0, 1), cA + hstep, voffA);
        if (wr == 1) PG8_BAR;
        PG8_WAIT_V(2); PG8_BAR;
        PG8_STAGE(PG8_SB(1, 0), cB + kstep, voffB); PG8_STAGE(PG8_SA(1, 0), cA + kstep, voffA); PG8_STAGE(PG8_SB(1, 1), cB + hstep + kstep, voffB);
        PG8_WAIT_V(6); PG8_BAR;
    } else {
        PG8_STAGE(PG8_SB(0, 0), cB, voffB); PG8_STAGE(PG8_SA(0, 0), cA, voffA); PG8_STAGE(PG8_SB(0, 1), cB + hstep, voffB); PG8_STAGE(PG8_SA(0, 1), cA + hstep, voffA);
        if (wr == 1) PG8_BAR;
        PG8_WAIT_V(4); PG8_BAR;
        PG8_STAGE(PG8_SB(1, 0), cB + kstep, voffB); PG8_STAGE(PG8_SA(1, 0), cA + kstep, voffA); PG8_STAGE(PG8_SB(1, 1), cB + hstep + kstep, voffB);
        PG8_WAIT_V(6); PG8_BAR;
    }
    for (;;) {
        const bool has_next = S.next(ui + 1, nxt);
        const char* nA = has_next ? (const char*)g.A + (size_t)nxt.pa * tstep : cA; const char* nB = has_next ? (const char*)g.Bt + (size_t)nxt.pb * tstep : cB;
        for (int t = 0; t < nt; t += 2) {
            const bool last = (t == nt - 2);
            const char* a1 = cA + (size_t)(t + 1) * kstep;
            const char* a2 = last ? nA : cA + (size_t)(t + 2) * kstep; const char* b2 = last ? nB : cB + (size_t)(t + 2) * kstep;
            const char* a3 = a2 + kstep; const char* b3 = b2 + kstep;
            if constexpr (SP2) {
            PG8_LDB(B0, 0, 0); PG8_LDB(B1, 0, 1); PG8_SCHED; PG8_LDA(At, 0, 0); PG8_STAGE(PG8_SA(1, 1), a1 + hstep, voffA);
            PG8_WAIT_V(8); PG8_WAIT_L(0); PG8_BAR; PG8_MMA(0, 0, At, B0); PG8_MMA(0, 1, At, B1); PG8_BAR; PG8_SCHED;
            PG8_LDA(At, 0, 1); PG8_STAGE(PG8_SB(0, 0), b2, voffB); PG8_STAGE(PG8_SB(0, 1), b2 + hstep, voffB); PG8_STAGE(PG8_SA(0, 0), a2, voffA);
            PG8_WAIT_V(8); PG8_WAIT_L(0); PG8_BAR; PG8_MMA(1, 0, At, B0); PG8_MMA(1, 1, At, B1); PG8_BAR; PG8_SCHED;
            PG8_LDB(B0, 1, 0); PG8_LDB(B1, 1, 1); PG8_SCHED; PG8_LDA(At, 1, 0); PG8_STAGE(PG8_SA(0, 1), a2 + hstep, voffA);
            PG8_WAIT_V(8); PG8_WAIT_L(0); PG8_BAR; PG8_MMA(0, 0, At, B0); PG8_MMA(0, 1, At, B1); PG8_BAR; PG8_SCHED;
            PG8_LDA(At, 1, 1); PG8_STAGE(PG8_SB(1, 0), b3, voffB); PG8_STAGE(PG8_SB(1, 1), b3 + hstep, voffB); PG8_STAGE(PG8_SA(1, 0), a3, voffA);
            PG8_WAIT_V(8); PG8_WAIT_L(0); PG8_BAR; PG8_MMA(1, 0, At, B0); PG8_MMA(1, 1, At, B1); PG8_BAR; PG8_SCHED;
            } else {
            PG8_LDB(B0, 0, 0); PG8_SCHED; PG8_LDA(At, 0, 0); PG8_STAGE(PG8_SA(1, 1), a1 + hstep, voffA);
            PG8_WAIT_L(8); PG8_BAR; PG8_WAIT_L(0); PG8_MMA(0, 0, At, B0); PG8_BAR; PG8_SCHED;
            PG8_LDB(B1, 0, 1); PG8_STAGE(PG8_SB(0, 0), b2, voffB);
            PG8_BAR; PG8_WAIT_L(0); PG8_MMA(0, 1, At, B1); PG8_BAR;
            PG8_LDA(At, 0, 1); PG8_STAGE(PG8_SA(0, 0), a2, voffA);
            PG8_BAR; PG8_WAIT_L(0); PG8_MMA(1, 0, At, B0); PG8_BAR; PG8_SCHED;
            PG8_STAGE(PG8_SB(0, 1), b2 + hstep, voffB);
            PG8_WAIT_V(6); PG8_BAR; PG8_MMA(1, 1, At, B1); PG8_BAR;
            PG8_LDB(B0, 1, 0); PG8_SCHED; PG8_LDA(At, 1, 0); PG8_STAGE(PG8_SA(0, 1), a2 + hstep, voffA);
            PG8_WAIT_L(8); PG8_BAR; PG8_WAIT_L(0); PG8_MMA(0, 0, At, B0); PG8_BAR; PG8_SCHED;
            PG8_LDB(B1, 1, 1); PG8_STAGE(PG8_SB(1, 0), b3, voffB);
            PG8_BAR; PG8_WAIT_L(0); PG8_MMA(0, 1, At, B1); PG8_BAR;
            PG8_LDA(At, 1, 1); PG8_STAGE(PG8_SA(1, 0), a3, voffA);
            PG8_BAR; PG8_WAIT_L(0); PG8_MMA(1, 0, At, B0); PG8_BAR; PG8_SCHED;
            PG8_STAGE(PG8_SB(1, 1), b3 + hstep, voffB);
            PG8_WAIT_V(6); PG8_BAR; PG8_MMA(1, 1, At, B1); PG8_BAR;
            }
        }
        if constexpr (ALIGN_EPI) { if (wr == 0) PG8_BAR; }
        E(acc, cur, wr, wc, fr, fq);
        if (!has_next) break;
#pragma unroll
        for (int a = 0; a < 2; ++a)
#pragma unroll
            for (int b = 0; b < 2; ++b)
#pragma unroll
                for (int m = 0; m < 4; ++m)
#pragma unroll
                    for (int n = 0; n < 2; ++n) acc[a][b][m][n] = (f32x4){0.f, 0.f, 0.f, 0.f};
        cur = nxt; cA = nA; cB = nB; ++ui;
        if constexpr (ALIGN_EPI) { if (wr == 1) PG8_BAR; }
    }
    PG8_WAIT_V(0);
    if constexpr (!ALIGN_EPI) { if (wr == 0) PG8_BAR; }
    PG8_BAR;
#undef PG8_SA
#undef PG8_SB
#undef PG8_STAGE
#undef PG8_LDA
#undef PG8_LDB
#undef PG8_MMA
#undef PG8_WAIT_V
#undef PG8_WAIT_L
#undef PG8_BAR
#undef PG8_SCHED
}

typedef const f32x4 (&AccT)[2][2][4][2];

struct EpiBf16Plain {
    static constexpr bool PERM = true;
    bf16_t* O; int ldc;
    __device__ __forceinline__ void operator()(AccT acc, const Unit& u, int wr, int wc, int fr, int fq) const {
        const int row0 = u.pm * BM + wr * 64 + fr, col0 = u.pn * BM + wc * 32 + 8 * fq;
#pragma unroll
        for (int ai = 0; ai < 2; ++ai)
#pragma unroll
            for (int m = 0; m < 4; ++m) { bf16_t* rowp = O + (size_t)(row0 + ai * HALF + m * 16) * ldc + col0;
#pragma unroll
                for (int bj = 0; bj < 2; ++bj) { const f32x4 v0 = acc[ai][bj][m][0], v1 = acc[ai][bj][m][1];
                    u32x4 w; w.x = pk2(v0[0], v0[1]); w.y = pk2(v0[2], v0[3]); w.z = pk2(v1[0], v1[1]); w.w = pk2(v1[2], v1[3]);
                    *(u32x4*)(rowp + bj * HALF) = w; } }
    }
};
struct EpiProj {
    static constexpr bool PERM = true;
    bf16_t* O; float* AB;
    __device__ __forceinline__ void operator()(AccT acc, const Unit& u, int wr, int wc, int fr, int fq) const {
        const int row0 = u.pm * BM + wr * 64 + fr, col0 = u.pn * BM + wc * 32 + 8 * fq;
        const bool ab = (u.pn == 8) && (wc == 0) && (fq == 0);
#pragma unroll
        for (int ai = 0; ai < 2; ++ai)
#pragma unroll
            for (int m = 0; m < 4; ++m) { const int row = row0 + ai * HALF + m * 16; bf16_t* rowp = O + (size_t)row * 2816 + col0;
#pragma unroll
                for (int bj = 0; bj < 2; ++bj) { const f32x4 v0 = acc[ai][bj][m][0], v1 = acc[ai][bj][m][1];
                    u32x4 w; w.x = pk2(v0[0], v0[1]); w.y = pk2(v0[2], v0[3]); w.z = pk2(v1[0], v1[1]); w.w = pk2(v1[2], v1[3]);
                    *(u32x4*)(rowp + bj * HALF) = w; }
                if (ab) { float* p = AB + (size_t)row * 8; *(f32x4*)p = acc[ai][0][m][0]; *(f32x4*)(p + 4) = acc[ai][0][m][1]; } }
    }
};
struct EpiSwiGLU {
    static constexpr bool PERM = true;
    bf16_t* O; int ldc;
    __device__ __forceinline__ void operator()(AccT acc, const Unit& u, int wr, int wc, int fr, int fq) const {
        const int row0 = u.pm * BM + wr * 64 + fr, col0 = u.pn * HALF + wc * 32 + 8 * fq;
#pragma unroll
        for (int ai = 0; ai < 2; ++ai)
#pragma unroll
            for (int m = 0; m < 4; ++m) { bf16_t* rowp = O + (size_t)(row0 + ai * HALF + m * 16) * ldc + col0;
                float r[8];
#pragma unroll
                for (int n = 0; n < 2; ++n)
#pragma unroll
                    for (int j = 0; j < 4; ++j) r[n * 4 + j] = silu_f(acc[ai][0][m][n][j]) * acc[ai][1][m][n][j];
                u32x4 w; w.x = pk2(r[0], r[1]); w.y = pk2(r[2], r[3]); w.z = pk2(r[4], r[5]); w.w = pk2(r[6], r[7]);
                *(u32x4*)rowp = w; }
    }
};
struct EpiGLU {
    static constexpr bool PERM = true;
    bf16_t* O; const float* bias;
    __device__ __forceinline__ void operator()(AccT acc, const Unit& u, int wr, int wc, int fr, int fq) const {
        const int row0 = u.pm * BM + wr * 64 + fr, col0 = u.pn * HALF + wc * 32 + 8 * fq;
        const f32x4 ba0 = *(const f32x4*)(bias + col0), ba1 = *(const f32x4*)(bias + col0 + 4), bb0 = *(const f32x4*)(bias + 512 + col0), bb1 = *(const f32x4*)(bias + 512 + col0 + 4);
#pragma unroll
        for (int ai = 0; ai < 2; ++ai)
#pragma unroll
            for (int m = 0; m < 4; ++m) { bf16_t* rowp = O + (size_t)(row0 + ai * HALF + m * 16) * 1024 + 512 + col0;
                const f32x4 a0 = acc[ai][0][m][0] + ba0, a1 = acc[ai][0][m][1] + ba1, b0 = acc[ai][1][m][0] + bb0, b1 = acc[ai][1][m][1] + bb1;
                u32x4 w; w.x = pk2(a0[0] * sigmoid_f(b0[0]), a0[1] * sigmoid_f(b0[1])); w.y = pk2(a0[2] * sigmoid_f(b0[2]), a0[3] * sigmoid_f(b0[3]));
                w.z = pk2(a1[0] * sigmoid_f(b1[0]), a1[1] * sigmoid_f(b1[1])); w.w = pk2(a1[2] * sigmoid_f(b1[2]), a1[3] * sigmoid_f(b1[3]));
                *(u32x4*)rowp = w; }
    }
};
template <bool XF32> struct EpiResidT {
    static constexpr bool PERM = true;
    const void* X; bf16_t* Y; const float* gate;
    __device__ __forceinline__ void operator()(AccT acc, const Unit& u, int wr, int wc, int fr, int fq) const {
        const int row0 = u.pm * BM + wr * 64 + fr, col0 = u.pn * BM + wc * 32 + 8 * fq;
        const float* gp = gate + (size_t)((u.pm * BM) >> 12) * 6144 + col0;
        f32x4 gv[2][2];
#pragma unroll
        for (int bj = 0; bj < 2; ++bj)
#pragma unroll
            for (int n = 0; n < 2; ++n) gv[bj][n] = *(const f32x4*)(gp + bj * HALF + 4 * n);
#pragma unroll
        for (int ai = 0; ai < 2; ++ai) {
            f32x4 xv[4][2][2];
            if (XF32) {
#pragma unroll
                for (int m = 0; m < 4; ++m)
#pragma unroll
                    for (int bj = 0; bj < 2; ++bj)
#pragma unroll
                        for (int n = 0; n < 2; ++n) xv[m][bj][n] = *(const f32x4*)((const float*)X + (size_t)(row0 + ai * HALF + m * 16) * 1024 + col0 + bj * HALF + 4 * n);
            } else {
                u32x4 xw[4][2];
#pragma unroll
                for (int m = 0; m < 4; ++m)
#pragma unroll
                    for (int bj = 0; bj < 2; ++bj) xw[m][bj] = *(const u32x4*)((const bf16_t*)X + (size_t)(row0 + ai * HALF + m * 16) * 1024 + col0 + bj * HALF);
#pragma unroll
                for (int m = 0; m < 4; ++m)
#pragma unroll
                    for (int bj = 0; bj < 2; ++bj) { const u32x4 w = xw[m][bj];
                        xv[m][bj][0] = (f32x4){bflo(w.x), bfhi(w.x), bflo(w.y), bfhi(w.y)}; xv[m][bj][1] = (f32x4){bflo(w.z), bfhi(w.z), bflo(w.w), bfhi(w.w)}; }
            }
            __builtin_amdgcn_sched_barrier(0);
#pragma unroll
            for (int m = 0; m < 4; ++m)
#pragma unroll
                for (int bj = 0; bj < 2; ++bj) { const f32x4 a = xv[m][bj][0] + gv[bj][0] * acc[ai][bj][m][0], c = xv[m][bj][1] + gv[bj][1] * acc[ai][bj][m][1];
                    u32x4 o; o.x = pk2(a[0], a[1]); o.y = pk2(a[2], a[3]); o.z = pk2(c[0], c[1]); o.w = pk2(c[2], c[3]);
                    *(u32x4*)(Y + (size_t)(row0 + ai * HALF + m * 16) * 1024 + col0 + bj * HALF) = o; }
            __builtin_amdgcn_sched_barrier(0);
        }
    }
};
struct EpiQKNorm {
    static constexpr bool PERM = true;
    bf16_t* Q; bf16_t* K; const float* qw; const float* kw;
    __device__ __forceinline__ void operator()(AccT acc, const Unit& u, int wr, int wc, int fr, int fq) const {
        const bool isK = u.pn >= 4;
        bf16_t* dst = isK ? K : Q; const float* wv = isK ? kw : qw; const float sc = isK ? 1.0f : 0.125f * 1.4426950408889634f;
        const int row0 = u.pm * BM + wr * 64 + fr, tc0 = (u.pn & 3) * BM + wc * 64;
        const float* wp = wv + 8 * fq;
        f32x4 wq[2][2];
#pragma unroll
        for (int bj = 0; bj < 2; ++bj) { wq[bj][0] = *(const f32x4*)(wp + 32 * bj); wq[bj][1] = *(const f32x4*)(wp + 32 * bj + 4); }
#pragma unroll
        for (int ai = 0; ai < 2; ++ai)
#pragma unroll
            for (int m = 0; m < 4; ++m) {
                float ss = 0.f;
#pragma unroll
                for (int bj = 0; bj < 2; ++bj)
#pragma unroll
                    for (int n = 0; n < 2; ++n) { const f32x4 x = acc[ai][bj][m][n]; ss += (x[0] * x[0] + x[1] * x[1]) + (x[2] * x[2] + x[3] * x[3]); }
                ss += __shfl_xor(ss, 16); ss += __shfl_xor(ss, 32);
                const float rs = __builtin_amdgcn_rsqf(ss * (1.0f / 64.0f) + 1e-6f) * sc;
                bf16_t* rowp = dst + (size_t)(row0 + ai * HALF + m * 16) * 1024 + tc0 + 8 * fq;
#pragma unroll
                for (int bj = 0; bj < 2; ++bj) { const f32x4 v0 = acc[ai][bj][m][0] * rs * wq[bj][0], v1 = acc[ai][bj][m][1] * rs * wq[bj][1];
                    u32x4 w; w.x = pk2(v0[0], v0[1]); w.y = pk2(v0[2], v0[3]); w.z = pk2(v1[0], v1[1]); w.w = pk2(v1[2], v1[3]);
                    *(u32x4*)(rowp + 32 * bj) = w; } }
    }
};
}
constexpr int D = 1024, NB = 4, SEQ = 4096, M = NB * SEQ, FF = 2816, NEXP = 8;
constexpr int EVEN_IN = 2568, EVEN_INP = 2816;
constexpr int MS = 2 * M + NEXP * 256;
constexpr int NWAVES = 8, NTHR = 512;
constexpr int LDS_BYTES = 147456;
constexpr int NPH = 36;

enum { I_X = 0, I_C, I_ADAW, I_ADAB, I_NMIX, I_NFFN, I_EWIN, I_ECONV, I_EALOG, I_EDTB, I_EGNW, I_ELRE, I_ELIM, I_ELSTEP, I_EBRE, I_EBIM, I_ECRE, I_ECIM,
       I_EDSKIP, I_EGLUW, I_EGLUB, I_EWOUT, I_EW13, I_EW2, I_OWQKV, I_OQNW, I_OKNW, I_OLQ1, I_OLK1, I_OLQ2, I_OLK2, I_OSUBLN, I_OWOUT, I_OROUTER, I_OEW13, I_OEW2, N_IN };

constexpr size_t al256(size_t x) { return (x + 255) & ~(size_t)255; }
constexpr size_t WS_CTL = 0;
constexpr size_t CTL_BYTES = 32768;
constexpr size_t CW_PQ = 14336;
constexpr size_t CW_CNT = 16384;
constexpr size_t WS_MOD = WS_CTL + CTL_BYTES;
constexpr size_t WS_COEF = WS_MOD + al256((size_t)4 * 4 * 6144 * 4);
constexpr size_t COEF_AR = 0, COEF_AI = 8192, COEF_A64R = 16384, COEF_A64I = 24576, COEF_BBR = 32768, COEF_BBI = 32768 + 131072, COEF_BYTES = 32768 + 2 * 131072;
constexpr size_t WS_META = WS_COEF + 2 * COEF_BYTES;
constexpr size_t WS_ROUTE = WS_META + 4096;
constexpr size_t WS_WIN = WS_ROUTE + (size_t)2 * M * 16;
constexpr size_t SZ_WIN = (size_t)EVEN_INP * D * 2;
constexpr size_t WS_GLU = WS_WIN + 2 * SZ_WIN;
constexpr size_t SZ_GLU = (size_t)1024 * 512 * 2;
constexpr size_t WS_WOE = WS_GLU + 2 * SZ_GLU;
constexpr size_t SZ_SQ = (size_t)D * D * 2;
constexpr size_t WS_W13 = WS_WOE + 2 * SZ_SQ;
constexpr size_t SZ_W13 = (size_t)2 * FF * D * 2;
constexpr size_t WS_W2 = WS_W13 + 2 * SZ_W13;
constexpr size_t SZ_W2 = (size_t)D * FF * 2;
constexpr size_t WS_WQK = WS_W2 + 2 * SZ_W2;
constexpr size_t SZ_WQK = (size_t)2048 * D * 2;
constexpr size_t WS_WV = WS_WQK + 2 * SZ_WQK;
constexpr size_t WS_WOO = WS_WV + 2 * SZ_SQ;
constexpr size_t WS_EW13 = WS_WOO + 2 * SZ_SQ;
constexpr size_t SZ_EW13 = (size_t)NEXP * SZ_W13;
constexpr size_t WS_EW2 = WS_EW13 + 2 * SZ_EW13;
constexpr size_t SZ_EW2 = (size_t)NEXP * SZ_W2;
constexpr size_t WS_H = WS_EW2 + 2 * SZ_EW2;
constexpr size_t WS_PROJ = WS_H + (size_t)M * D * 2;
constexpr size_t WS_QN = WS_PROJ, WS_KN = WS_QN + (size_t)M * D * 2, WS_VT = WS_KN + (size_t)M * D * 2;
constexpr size_t WS_AB = WS_PROJ + (size_t)M * EVEN_INP * 2;
constexpr size_t WS_GU = WS_AB + (size_t)M * 8 * 4;
constexpr size_t SZ_G128 = (size_t)1024 * 64 * 128 * 2;
constexpr size_t WS_GWN = WS_GU + SZ_G128, WS_GQG = WS_GWN + SZ_G128, WS_GKGT = WS_GQG + SZ_G128;
constexpr size_t WS_GQK = WS_GKGT + SZ_G128;
constexpr size_t WS_GL = WS_GQK + (size_t)1024 * 64 * 64 * 2;
constexpr size_t WS_OG = WS_GL + 4096;
constexpr size_t WS_S5E = WS_OG + (size_t)M * 512 * 4;
constexpr size_t WS_GY = WS_S5E + (size_t)4 * 64 * 32 * 64 * 8;
constexpr size_t WS_CAT = WS_GY + (size_t)M * 512 * 2;
constexpr size_t WS_ACT = WS_CAT + (size_t)M * D * 2;
constexpr size_t WS_ACTS = WS_ACT + (size_t)M * FF * 2;
constexpr size_t WS_FS = WS_ACTS + (size_t)MS * FF * 2;
constexpr size_t WS_GA = WS_FS + (size_t)MS * D * 2;
constexpr size_t WS_GBT = WS_GA + (size_t)1024 * 16384 * 2;
constexpr size_t WS_GST = WS_GBT + (size_t)1024 * 16384 * 2;
constexpr size_t WS_HS = WS_GST + (size_t)1024 * 16384 * 2;
constexpr size_t WS_DUMMY = WS_HS + (size_t)NEXP * M * D * 2;
constexpr size_t WS_XB = WS_DUMMY;
constexpr size_t WS_END = WS_DUMMY + (size_t)M * D * 4;

struct Route { int p0, p1; float g0, g1; };
struct TDesc { const float* src; bf16_t* dst; int ld, K, N, nblk, E, map, mp, item0; size_t src_es; int dst_erows; int pad_; };
constexpr int NDESC = 20;
struct Args {
    const float* in[N_IN];
    float* out; unsigned char* ws;
    TDesc td[NDESC];
    int n_items; int ph_lo, ph_hi, coop;
    int n_pro, cv_lo[2], cv_hi[2];
};

struct Ctx {
    LAS unsigned char* lds; int tid, lane, wave, G, bid, zero;
    const float* const* in; float* out; unsigned char* ws;
};

DI int td_maprow(int map, int mp, int n0) {
    if (map == 0) return n0;
    if (map == 1) { if (n0 < mp) return 256 * (n0 >> 7) + (n0 & 127); const int n1 = n0 - mp; return 256 * (n1 >> 7) + 128 + (n1 & 127); }
    const int pn = n0 >> 8, r = n0 & 255, wc = r >> 6, bj = (r & 63) >> 5; return 256 * pn + 128 * bj + 32 * wc;
}
DI void p0_transpose_item(const TDesc& t, int item, int lane) {
    const int per_e = (t.K >> 6) * t.nblk; const int e = item / per_e, r = item - e * per_e, kb = r / t.nblk, nb = r - kb * t.nblk, k0 = 64 * kb, n0 = 32 * nb;
    const int g = lane >> 3, c4 = lane & 7, col = n0 + 4 * c4; const bool ok = col < t.N;
    const float* W = t.src + (size_t)e * t.src_es + (size_t)(k0 + 8 * g) * t.ld + col;
    f32x4 v[8];
#pragma unroll
    for (int i = 0; i < 8; ++i) v[i] = ok ? *(const f32x4*)(W + (size_t)i * t.ld) : (f32x4){0.f, 0.f, 0.f, 0.f};
    const int drow0 = td_maprow(t.map, t.mp, n0) + e * t.dst_erows + 4 * c4;
    bf16_t* dp = t.dst + (size_t)drow0 * t.K + k0 + 8 * g;
#pragma unroll
    for (int q = 0; q < 4; ++q) { u32x4 o; o.x = pk2(v[0][q], v[1][q]); o.y = pk2(v[2][q], v[3][q]); o.z = pk2(v[4][q], v[5][q]); o.w = pk2(v[6][q], v[7][q]);
        *(u32x4*)(dp + (size_t)q * t.K) = o; }
}
#define CAS __attribute__((address_space(4)))
DI const CAS Args* kargs() { return (const CAS Args*)__builtin_amdgcn_kernarg_segment_ptr(); }
struct ConvSt { f32x4 v[8]; unsigned doff;
    bf16_t* db; int K, hi;
    int next, end, di, pend; };
DI void cv_init(ConvSt& S, int lo, int hi, int gw) { S.next = lo + gw; S.end = hi; S.di = 0; S.pend = 0; S.doff = 0u; S.db = nullptr; S.K = 64; S.hi = 0;
#pragma unroll
    for (int i = 0; i < 8; ++i) S.v[i] = (f32x4){0.f, 0.f, 0.f, 0.f}; }
DI void cv_issue(ConvSt& S, int lane, int stride) {
    const int it = S.next; S.next += stride; const CAS Args* A = kargs();
    if (it >= S.hi) {
        int di = S.di;
        while (di + 1 < NDESC && it >= A->td[di + 1].item0) ++di;
        S.di = di; S.db = A->td[di].dst; S.K = A->td[di].K; S.hi = (di + 1 < NDESC) ? A->td[di + 1].item0 : 0x7fffffff;
    }
    const CAS TDesc* t = &A->td[S.di];
    const int K = S.K, nblk = t->nblk, ld = t->ld, item = it - t->item0;
    const int per_e = (K >> 6) * nblk; const int e = item / per_e, r = item - e * per_e, kb = r / nblk, nb = r - kb * nblk, k0 = 64 * kb, n0 = 32 * nb;
    const int g = lane >> 3, c4 = lane & 7, col = n0 + 4 * c4; const bool ok = col < t->N;
    const float* W = t->src + (size_t)e * t->src_es + (size_t)(k0 + 8 * g) * ld + col;
#pragma unroll
    for (int i = 0; i < 8; ++i) S.v[i] = ok ? *(const f32x4*)(W + (size_t)i * ld) : (f32x4){0.f, 0.f, 0.f, 0.f};
    const int drow0 = td_maprow(t->map, t->mp, n0) + e * t->dst_erows + 4 * c4;
    S.doff = (unsigned)(((size_t)drow0 * K + k0 + 8 * g) * 2); S.pend = 1;
}
DI void cv_finish(ConvSt& S) {
    unsigned char* dp = (unsigned char*)S.db + S.doff;
#pragma unroll
    for (int q = 0; q < 4; ++q) { u32x4 o; o.x = pk2(S.v[0][q], S.v[1][q]); o.y = pk2(S.v[2][q], S.v[3][q]); o.z = pk2(S.v[4][q], S.v[5][q]); o.w = pk2(S.v[6][q], S.v[7][q]);
        *(u32x4*)(dp + (size_t)q * S.K * 2) = o; }
    S.pend = 0;
}
#define CV_STEP(S, LANE, STRIDE) do { if ((S).pend) cv_finish(S); if ((S).next < (S).end) cv_issue(S, LANE, STRIDE); } while (0)
#define CV_DRAIN(S, LANE, STRIDE) do { while ((S).pend || (S).next < (S).end) { if ((S).pend) cv_finish(S); if ((S).next < (S).end) cv_issue(S, LANE, STRIDE); } } while (0)
DI void p0_prologue(const Ctx& C, const Args& A) {
    {
        LAS float* red = (LAS float*)(C.lds + 16384);
        LAS float* cond = (LAS float*)(C.lds);
        const float* cc = C.in[C.zero + I_C];
        for (int k = C.tid; k < 4 * D; k += NTHR) { const float x = cc[k]; cond[k] = x / (1.0f + expf(-x)); }
        __syncthreads();
        for (int it = C.bid; it < 4 * 24; it += C.G) {
            const int l = it / 24, jb = it - l * 24, j = 256 * jb + 4 * C.lane;
            const float* W = C.in[C.zero + I_ADAW] + (size_t)l * D * 6144 + (size_t)(128 * C.wave) * 6144 + j;
            f32x4 a0 = {0.f, 0.f, 0.f, 0.f}, a1 = a0, a2 = a0, a3 = a0;
#pragma unroll 8
            for (int k = 0; k < 128; ++k) { const f32x4 w = *(const f32x4*)(W + (size_t)k * 6144); const int kk = 128 * C.wave + k;
                a0 += w * cond[kk]; a1 += w * cond[D + kk]; a2 += w * cond[2 * D + kk]; a3 += w * cond[3 * D + kk]; }
            *(LAS f32x4*)(red + (C.wave * 4 + 0) * 256 + 4 * C.lane) = a0; *(LAS f32x4*)(red + (C.wave * 4 + 1) * 256 + 4 * C.lane) = a1;
            *(LAS f32x4*)(red + (C.wave * 4 + 2) * 256 + 4 * C.lane) = a2; *(LAS f32x4*)(red + (C.wave * 4 + 3) * 256 + 4 * C.lane) = a3;
            __syncthreads();
            if (C.wave < 4) { f32x4 s = *(const f32x4*)(C.in[C.zero + I_ADAB] + (size_t)l * 6144 + j);
#pragma unroll
                for (int w = 0; w < 8; ++w) s += *(const LAS f32x4*)(red + (w * 4 + C.wave) * 256 + 4 * C.lane);
                *(f32x4*)((float*)(C.ws + WS_MOD) + ((size_t)l * 4 + C.wave) * 6144 + j) = s; }
            __syncthreads();
        }
        __syncthreads();
    }
    for (int id = C.bid * NTHR + C.tid; id < 2 * 2048; id += C.G * NTHR) {
        const int i = id >> 11, gn = id & 2047, g = gn >> 6;
        double lr = (double)C.in[C.zero + I_ELRE][i * 2048 + gn]; if (lr > -1e-4) lr = -1e-4;
        const double li = (double)C.in[C.zero + I_ELIM][i * 2048 + gn], dt = exp((double)C.in[C.zero + I_ELSTEP][i * 32 + g]);
        const double mag = exp(lr * dt), ar = mag * cos(li * dt), ai = mag * sin(li * dt), nr = ar - 1.0, ni = ai, den = lr * lr + li * li;
        const double cr = (nr * lr + ni * li) / den, ci = (ni * lr - nr * li) / den;
        const double m64 = exp(256.0 * lr * dt), a64r = m64 * cos(256.0 * li * dt), a64i = m64 * sin(256.0 * li * dt);
        unsigned char* cf = C.ws + WS_COEF + (size_t)i * COEF_BYTES;
        ((float*)(cf + COEF_AR))[gn] = (float)ar; ((float*)(cf + COEF_AI))[gn] = (float)ai; ((float*)(cf + COEF_A64R))[gn] = (float)a64r; ((float*)(cf + COEF_A64I))[gn] = (float)a64i;
        const float* bre = C.in[C.zero + I_EBRE] + ((size_t)i * 2048 + gn) * 16; const float* bim = C.in[C.zero + I_EBIM] + ((size_t)i * 2048 + gn) * 16;
#pragma unroll
        for (int c = 0; c < 16; ++c) { const double br = bre[c], bi = bim[c];
            ((float*)(cf + COEF_BBR))[gn * 16 + c] = (float)(cr * br - ci * bi); ((float*)(cf + COEF_BBI))[gn * 16 + c] = (float)(cr * bi + ci * br); }
    }
    {
        unsigned* qhead = (unsigned*)(C.ws + WS_CTL + CW_PQ);
        int di = 0;
        for (;;) {
            unsigned it0 = 0u;
            if (C.lane == 0) it0 = __hip_atomic_fetch_add(qhead, 8u, __ATOMIC_RELAXED, __HIP_MEMORY_SCOPE_AGENT);
            it0 = (unsigned)__builtin_amdgcn_readfirstlane((int)it0);
            if (it0 >= (unsigned)A.n_pro) break;
#pragma unroll 1
            for (int q = 0; q < 8; ++q) { const int it = (int)it0 + q; if (it >= A.n_pro) break;
                while (di + 1 < NDESC && it >= A.td[di + 1].item0) ++di;
                p0_transpose_item(A.td[di], it - A.td[di].item0, C.lane); }
        }
    }
}

DI int opv2_(int x) { asm volatile("" : "+v"(x)); return x; }
DI u32x4 pack8f(const f32x4 a, const f32x4 b) { u32x4 o; o.x = pk2(a[0], a[1]); o.y = pk2(a[2], a[3]); o.z = pk2(b[0], b[1]); o.w = pk2(b[2], b[3]); return o; }
template <bool COMBINE, bool NORM, bool ROUTER, bool XF32, bool OUTF32 = false, int RB = (COMBINE || ROUTER) ? 2 : 4>
DI void norm_phase(const Ctx& C, const void* xsrc, void* xdst, const float* nw, const float* modl, int sc_off, int sh_off, bf16_t* H,
                   const Route* rprev, const bf16_t* FS, const float* g2prev, const unsigned* cntprev, const float* rw, unsigned* cnt, Route* rout, bf16_t* HSx) {
    const int gw = C.bid * NWAVES + C.wave, NGW = C.G * NWAVES;
    int coff[8];
    if (COMBINE) { int acc = 0;
#pragma unroll
        for (int e = 0; e < 8; ++e) { coff[e] = acc; acc += ((int)__hip_atomic_load(cntprev + 64 * e, __ATOMIC_RELAXED, __HIP_MEMORY_SCOPE_AGENT) + 255) & ~255; } }
    LAS f32x4* RW0 = (LAS f32x4*)(C.lds); LAS f32x4* RW1 = (LAS f32x4*)(C.lds + 16384);
    if (ROUTER) {
        for (int col = C.tid; col < D; col += NTHR) { const int ix = ((col >> 9) * 8 + (col & 7)) * 64 + ((col & 511) >> 3);
            RW0[ix] = *(const f32x4*)(rw + (size_t)col * 8); RW1[ix] = *(const f32x4*)(rw + (size_t)col * 8 + 4); }
        __syncthreads();
    }
    f32x4 gsc[4], shv[4]; int bcur = -1;
    for (int row0 = gw * RB; row0 < M; row0 += NGW * RB) {
        const int b = row0 >> 12;
        f32x4 v[RB][4];
        if (XF32) {
#pragma unroll
            for (int i = 0; i < RB; ++i)
#pragma unroll
                for (int q = 0; q < 4; ++q) v[i][q] = *(const f32x4*)((const float*)xsrc + (size_t)(row0 + i) * D + 8 * C.lane + 512 * (q >> 1) + 4 * (q & 1));
        } else {
            u32x4 xw[RB][2];
#pragma unroll
            for (int i = 0; i < RB; ++i)
#pragma unroll
                for (int j2 = 0; j2 < 2; ++j2) xw[i][j2] = *(const u32x4*)((const bf16_t*)xsrc + (size_t)(row0 + i) * D + 8 * C.lane + 512 * j2);
#pragma unroll
            for (int i = 0; i < RB; ++i)
#pragma unroll
                for (int j2 = 0; j2 < 2; ++j2) { const u32x4 w = xw[i][j2];
                    v[i][2 * j2] = (f32x4){bflo(w.x), bfhi(w.x), bflo(w.y), bfhi(w.y)}; v[i][2 * j2 + 1] = (f32x4){bflo(w.z), bfhi(w.z), bflo(w.w), bfhi(w.w)}; }
        }
        if (NORM && b != bcur) { bcur = b;
#pragma unroll
            for (int q = 0; q < 4; ++q) { const int c = 8 * C.lane + 512 * (q >> 1) + 4 * (q & 1);
                gsc[q] = *(const f32x4*)(nw + c) * (*(const f32x4*)(modl + (size_t)b * 6144 + sc_off + c) + 1.0f); shv[q] = *(const f32x4*)(modl + (size_t)b * 6144 + sh_off + c); } }
        if (COMBINE) {
            Route r[RB];
#pragma unroll
            for (int i = 0; i < RB; ++i) { r[i] = rprev[row0 + i];
                int o0 = 0, o1 = 0; const int e0 = r[i].p0 >> 24, e1 = r[i].p1 >> 24;
#pragma unroll
                for (int e = 0; e < 8; ++e) { o0 = (e == e0) ? coff[e] : o0; o1 = (e == e1) ? coff[e] : o1; }
                r[i].p0 = o0 + (r[i].p0 & 0xffffff); r[i].p1 = o1 + (r[i].p1 & 0xffffff); }
            u32x4 f0[RB][2], f1[RB][2];
#pragma unroll
            for (int i = 0; i < RB; ++i)
#pragma unroll
                for (int j2 = 0; j2 < 2; ++j2) { const int c = 8 * C.lane + 512 * j2; f0[i][j2] = *(const u32x4*)(FS + (size_t)r[i].p0 * D + c); f1[i][j2] = *(const u32x4*)(FS + (size_t)r[i].p1 * D + c); }
#pragma unroll
            for (int j2 = 0; j2 < 2; ++j2) { const int c = 8 * C.lane + 512 * j2;
                const f32x4 ga = *(const f32x4*)(g2prev + (size_t)b * 6144 + c), gb = *(const f32x4*)(g2prev + (size_t)b * 6144 + c + 4);
#pragma unroll
                for (int i = 0; i < RB; ++i) { const u32x4 a = f0[i][j2], d = f1[i][j2]; const float g0 = r[i].g0, g1 = r[i].g1; f32x4 fa, fb;
                    fa[0] = g0 * bflo(a.x) + g1 * bflo(d.x); fa[1] = g0 * bfhi(a.x) + g1 * bfhi(d.x); fa[2] = g0 * bflo(a.y) + g1 * bflo(d.y); fa[3] = g0 * bfhi(a.y) + g1 * bfhi(d.y);
                    fb[0] = g0 * bflo(a.z) + g1 * bflo(d.z); fb[1] = g0 * bfhi(a.z) + g1 * bfhi(d.z); fb[2] = g0 * bflo(a.w) + g1 * bflo(d.w); fb[3] = g0 * bfhi(a.w) + g1 * bfhi(d.w);
                    v[i][2 * j2] = v[i][2 * j2] + ga * fa; v[i][2 * j2 + 1] = v[i][2 * j2 + 1] + gb * fb;
                    if (OUTF32) { *(f32x4*)((float*)xdst + (size_t)(row0 + i) * D + c) = v[i][2 * j2]; *(f32x4*)((float*)xdst + (size_t)(row0 + i) * D + c + 4) = v[i][2 * j2 + 1]; }
                    else { const u32x4 o = pack8f(v[i][2 * j2], v[i][2 * j2 + 1]); *(u32x4*)((bf16_t*)xdst + (size_t)(row0 + i) * D + c) = o;
                        if (NORM) { v[i][2 * j2] = (f32x4){bflo(o.x), bfhi(o.x), bflo(o.y), bfhi(o.y)}; v[i][2 * j2 + 1] = (f32x4){bflo(o.z), bfhi(o.z), bflo(o.w), bfhi(o.w)}; } } } }
        }
        if (NORM) {
            float rs[RB];
#pragma unroll
            for (int i = 0; i < RB; ++i) { float ss = 0.f;
#pragma unroll
                for (int q = 0; q < 4; ++q) ss += (v[i][q][0] * v[i][q][0] + v[i][q][1] * v[i][q][1]) + (v[i][q][2] * v[i][q][2] + v[i][q][3] * v[i][q][3]);
                ss = wave_sum(ss); rs[i] = 1.0f / sqrtf(ss * (1.0f / D) + 1e-6f); }
            float lg[RB][8]; u32x4 hpk[RB][2];
            const int Lr = ROUTER ? opv2_(C.lane) : 0;
            if (ROUTER) {
#pragma unroll
                for (int i = 0; i < RB; ++i)
#pragma unroll
                    for (int e = 0; e < 8; ++e) lg[i][e] = 0.f; }
#pragma unroll
            for (int j2 = 0; j2 < 2; ++j2) { const int c = 8 * C.lane + 512 * j2;
                f32x4 hv[RB][2];
#pragma unroll
                for (int i = 0; i < RB; ++i) { hv[i][0] = (v[i][2 * j2] * rs[i]) * gsc[2 * j2] + shv[2 * j2]; hv[i][1] = (v[i][2 * j2 + 1] * rs[i]) * gsc[2 * j2 + 1] + shv[2 * j2 + 1];
                    const u32x4 o = pack8f(hv[i][0], hv[i][1]);
                    if (ROUTER) hpk[i][j2] = o; else *(u32x4*)(H + (size_t)(row0 + i) * D + c) = o; }
                if (ROUTER) {
#pragma unroll
                    for (int q = 0; q < 8; ++q) { const f32x4 r0 = RW0[(j2 * 8 + q) * 64 + Lr], r1 = RW1[(j2 * 8 + q) * 64 + Lr];
#pragma unroll
                        for (int i = 0; i < RB; ++i) { const float x = hv[i][q >> 2][q & 3];
                            lg[i][0] += x * r0[0]; lg[i][1] += x * r0[1]; lg[i][2] += x * r0[2]; lg[i][3] += x * r0[3];
                            lg[i][4] += x * r1[0]; lg[i][5] += x * r1[1]; lg[i][6] += x * r1[2]; lg[i][7] += x * r1[3]; } } }
            }
            if (ROUTER) {
#pragma unroll
                for (int i = 0; i < RB; ++i) { const int row = row0 + i;
#pragma unroll
                    for (int e = 0; e < 8; ++e) lg[i][e] = wave_sum(lg[i][e]);
                    int e0 = 0; float v0 = lg[i][0];
#pragma unroll
                    for (int e = 1; e < 8; ++e) if (lg[i][e] > v0) { v0 = lg[i][e]; e0 = e; }
                    int e1 = -1; float v1 = -3.0e38f;
#pragma unroll
                    for (int e = 0; e < 8; ++e) if (e != e0 && lg[i][e] > v1) { v1 = lg[i][e]; e1 = e; }
                    unsigned s0 = 0u, s1 = 0u;
                    if (C.lane == 0) {
                        const float g0 = 1.0f / (1.0f + __expf(v1 - v0));
                        s0 = __hip_atomic_fetch_add(cnt + 64 * e0, 1u, __ATOMIC_RELAXED, __HIP_MEMORY_SCOPE_AGENT);
                        s1 = __hip_atomic_fetch_add(cnt + 64 * e1, 1u, __ATOMIC_RELAXED, __HIP_MEMORY_SCOPE_AGENT);
                        Route r; r.p0 = (e0 << 24) | (int)s0; r.p1 = (e1 << 24) | (int)s1; r.g0 = g0; r.g1 = 1.0f - g0;
                        rout[row] = r;
                    }
                    s0 = (unsigned)__builtin_amdgcn_readfirstlane((int)s0); s1 = (unsigned)__builtin_amdgcn_readfirstlane((int)s1);
                    bf16_t* d0 = HSx + ((size_t)e0 * M + s0) * D + 8 * C.lane; bf16_t* d1 = HSx + ((size_t)e1 * M + s1) * D + 8 * C.lane;
#pragma unroll
                    for (int j2 = 0; j2 < 2; ++j2) { *(u32x4*)(d0 + 512 * j2) = hpk[i][j2]; *(u32x4*)(d1 + 512 * j2) = hpk[i][j2]; } }
            }
        }
    }
}
DI f32x4 mfma16(bf16x8 a, bf16x8 b, f32x4 c) { return __builtin_amdgcn_mfma_f32_16x16x32_bf16(a, b, c, 0, 0, 0); }
DI f32x16 mfma32(bf16x8 a, bf16x8 b, f32x16 c) { return __builtin_amdgcn_mfma_f32_32x32x16_bf16(a, b, c, 0, 0, 0); }
DI bf16x8 pack8(f32x4 lo, f32x4 hi) { u32x4 p; p.x = pk2(lo[0], lo[1]); p.y = pk2(lo[2], lo[3]); p.z = pk2(hi[0], hi[1]); p.w = pk2(hi[2], hi[3]); return __builtin_bit_cast(bf16x8, p); }
DI bf16x8 join8(s16x4 lo, s16x4 hi) { return __builtin_shufflevector(lo, hi, 0, 1, 2, 3, 4, 5, 6, 7); }

DI int opv_(int x) { asm volatile("" : "+v"(x)); return x; }
DI void gdn_a_phase(const Ctx& C, int ie) {
    ConvSt cv; cv_init(cv, kargs()->cv_lo[ie], kargs()->cv_hi[ie], C.bid * NWAVES + C.wave);
    const int cvs = C.G * NWAVES;
#define GA_BAR0() do { asm volatile("s_waitcnt lgkmcnt(0)" ::: "memory"); __builtin_amdgcn_s_barrier(); asm volatile("" ::: "memory"); } while (0)
#define GA_BAR() do { CV_STEP(cv, L.lane, cvs); asm volatile("s_waitcnt lgkmcnt(0)" ::: "memory"); __builtin_amdgcn_s_barrier(); asm volatile("" ::: "memory"); } while (0)
    if (C.bid < 1024) {
    const int h = (C.bid >> 6) & 3;
    LAS float* mm = (LAS float*)(C.lds); LAS unsigned char* vb = C.lds + 17408; LAS unsigned char* uwt = C.lds; LAS float* solL = (LAS float*)(C.lds + 36864);
    LAS unsigned char* raw = C.lds + 36864;
    LAS unsigned char* qb = C.lds + 102400; LAS unsigned char* kb = C.lds + 119808;
    LAS float* beta = (LAS float*)(C.lds + 137216); LAS float* gc = (LAS float*)(C.lds + 137472); LAS float* eg = (LAS float*)(C.lds + 137728);
    LAS unsigned char* qkl = C.lds + 137984;
    const bf16_t* PROJ = (const bf16_t*)(C.ws + WS_PROJ);
    const float* convw = C.in[C.zero + I_ECONV] + (size_t)ie * 4 * 1536;
    const float dtb = C.in[C.zero + I_EDTB][ie * 4 + h], nalog = -expf(C.in[C.zero + I_EALOG][ie * 4 + h]);
    u32x4 rv[7]; float abb = 0.f, aba = 0.f;
#define GA_LOAD(un, TID, LANE) do { const int b_ = (un) >> 8, n_ = (un) & 63; \
        _Pragma("unroll") for (int i = 0; i < 7; ++i) { const int p = (TID) + 512 * i; rv[i] = (u32x4){0u, 0u, 0u, 0u}; \
            if (p < 67 * 48) { const int rr = p / 48, c = p - rr * 48, which = c >> 4, pc = c & 15, pos = n_ * 64 + rr - 3; \
                if (pos >= 0) rv[i] = *(const u32x4*)(PROJ + (size_t)(b_ * SEQ + pos) * EVEN_INP + which * 512 + h * 128 + pc * 8); } } \
        if (C.wave == 0) { const float* AB_ = (const float*)(C.ws + WS_AB) + (size_t)(b_ * SEQ + n_ * 64 + (LANE)) * 8; abb = AB_[h]; aba = AB_[4 + h]; } } while (0)
    GA_LOAD(C.bid, C.tid, C.lane);
#pragma unroll 1
    for (int unit = C.bid; unit < 1024; unit += C.G) {
    Ctx L; L.tid = opv_(C.tid); L.lane = L.tid & 63;
    float cw[6][4];
#pragma unroll
    for (int ch = 0; ch < 6; ++ch)
#pragma unroll
        for (int j = 0; j < 4; ++j) cw[ch][j] = convw[j * 1536 + (ch >> 1) * 512 + h * 128 + (ch & 1) * 64 + L.lane];
#pragma unroll
    for (int i = 0; i < 7; ++i) { const int p = L.tid + 512 * i; if (p < 67 * 48) { const int rr = p / 48, c = p - rr * 48; *(LAS u32x4*)(raw + rr * 768 + c * 16) = rv[i]; } }
    const float bv = abb, av = aba + dtb;
    GA_BAR0();
    {
        float w0[6], w1[6], w2[6];
#pragma unroll
        for (int ch = 0; ch < 6; ++ch) { const LAS unsigned char* rp = raw + (8 * C.wave) * 768 + ((ch >> 1) * 128 + (ch & 1) * 64 + L.lane) * 2;
            w0[ch] = bf2f(*(const LAS bf16_t*)(rp)); w1[ch] = bf2f(*(const LAS bf16_t*)(rp + 768)); w2[ch] = bf2f(*(const LAS bf16_t*)(rp + 1536)); }
#pragma unroll
        for (int rr = 0; rr < 8; ++rr) { const int t = 8 * C.wave + rr; float o[6];
#pragma unroll
            for (int ch = 0; ch < 6; ++ch) { const float x3 = bf2f(*(const LAS bf16_t*)(raw + (t + 3) * 768 + ((ch >> 1) * 128 + (ch & 1) * 64 + L.lane) * 2));
                const float a = cw[ch][0] * w0[ch] + cw[ch][1] * w1[ch] + cw[ch][2] * w2[ch] + cw[ch][3] * x3;
                w0[ch] = w1[ch]; w1[ch] = w2[ch]; w2[ch] = x3; o[ch] = a / (1.0f + __expf(-a)); }
            const float sq = wave_sum(o[0] * o[0] + o[1] * o[1]), sk = wave_sum(o[2] * o[2] + o[3] * o[3]);
            const float rq = (1.0f / sqrtf(sq + 1e-6f)) * 0.08838834764831845f, rk = 1.0f / sqrtf(sk + 1e-6f);
            *(LAS bf16_t*)(qb + t * 272 + L.lane * 2) = f2bf(o[0] * rq); *(LAS bf16_t*)(qb + t * 272 + (64 + L.lane) * 2) = f2bf(o[1] * rq);
            *(LAS bf16_t*)(kb + t * 272 + L.lane * 2) = f2bf(o[2] * rk); *(LAS bf16_t*)(kb + t * 272 + (64 + L.lane) * 2) = f2bf(o[3] * rk);
            *(LAS bf16_t*)(vb + t * 272 + L.lane * 2) = f2bf(o[4]); *(LAS bf16_t*)(vb + t * 272 + (64 + L.lane) * 2) = f2bf(o[5]); }
    }
    if (C.wave == 0) {
        const float sp = (av > 20.f) ? av : log1pf(expf(av));
        float g = nalog * sp;
#pragma unroll
        for (int o = 1; o < 64; o <<= 1) { const float u = __shfl_up(g, o); if (L.lane >= o) g += u; }
        beta[L.lane] = 1.0f / (1.0f + expf(-bv)); gc[L.lane] = g; eg[L.lane] = expf(g);
    }
    GA_BAR();
    if (unit + C.G < 1024) GA_LOAD(unit + C.G, L.tid, L.lane);
    {
        const int ti = C.wave >> 1, r16 = L.lane & 15, q4 = L.lane >> 4;
#pragma unroll
        for (int tt = 0; tt < 2; ++tt) { const int tj = 2 * (C.wave & 1) + tt;
            f32x4 akk = {0.f, 0.f, 0.f, 0.f}, aqk = {0.f, 0.f, 0.f, 0.f};
#pragma unroll
            for (int ks = 0; ks < 4; ++ks) {
                const bf16x8 ak = *(const LAS bf16x8*)(kb + (16 * ti + r16) * 272 + ks * 64 + q4 * 16);
                const bf16x8 aq = *(const LAS bf16x8*)(qb + (16 * ti + r16) * 272 + ks * 64 + q4 * 16);
                const bf16x8 bk = *(const LAS bf16x8*)(kb + (16 * tj + r16) * 272 + ks * 64 + q4 * 16);
                akk = mfma16(ak, bk, akk); aqk = mfma16(aq, bk, aqk); }
            const int j = 16 * tj + r16; const float gj = gc[j];
#pragma unroll
            for (int rg = 0; rg < 4; ++rg) { const int i = 16 * ti + 4 * q4 + rg; const float dec = (i >= j) ? __expf(gc[i] - gj) : 0.f;
                mm[i * 68 + j] = (i > j) ? beta[i] * akk[rg] * dec : 0.f;
                *(LAS bf16_t*)(qkl + i * 144 + j * 2) = f2bf(aqk[rg] * dec); }
        }
    }
    GA_BAR0();
    LAS float* Tl = (LAS float*)(C.lds + 34816);
    if (L.tid < 64) {
        const int Bq = L.tid >> 4, j = L.tid & 15; float tcol[16];
#pragma unroll
        for (int i = 0; i < 16; ++i) { float a = (i == j) ? 1.0f : 0.0f;
#pragma unroll
            for (int q = 0; q < (i + 3) / 4; ++q) { const f32x4 mv = *(const LAS f32x4*)(mm + (16 * Bq + i) * 68 + 16 * Bq + 4 * q);
#pragma unroll
                for (int jj = 0; jj < 4; ++jj) if (4 * q + jj < i) a -= mv[jj] * tcol[4 * q + jj]; }
            tcol[i] = a; Tl[(Bq * 16 + i) * 16 + j] = a; }
    } else if (L.tid >= 256) {
        const int t2 = L.tid - 256;
        bf16_t* QG = (bf16_t*)(C.ws + WS_GQG) + (size_t)unit * 8192; bf16_t* QKM = (bf16_t*)(C.ws + WS_GQK) + (size_t)unit * 4096;
        for (int idx = t2; idx < 64 * 128; idx += 256) { const int t = idx >> 7, d = idx & 127;
            QG[idx] = f2bf(bf2f(*(const LAS bf16_t*)(qb + t * 272 + d * 2)) * eg[t]); }
#pragma unroll
        for (int i = 0; i < 2; ++i) { const int p = t2 + 256 * i; *(u32x4*)(QKM + p * 8) = *(const LAS u32x4*)(qkl + (p >> 3) * 144 + (p & 7) * 16); }
        if (t2 == 0) ((float*)(C.ws + WS_GL))[unit] = expf(gc[63]);
    }
    GA_BAR();
    {
        const int r16 = L.lane & 15, q4 = L.lane >> 4;
        float tf[4][4];
#pragma unroll
        for (int Bq = 0; Bq < 4; ++Bq)
#pragma unroll
            for (int ks = 0; ks < 4; ++ks) tf[Bq][ks] = Tl[(Bq * 16 + r16) * 16 + 4 * ks + q4];
        GA_BAR0();
        bf16_t* Ug = (bf16_t*)(C.ws + WS_GU) + (size_t)unit * 8192; bf16_t* Wg = (bf16_t*)(C.ws + WS_GWN) + (size_t)unit * 8192;
#pragma unroll 1
        for (int cc = 0; cc < 2; ++cc) {
            const int c = 32 * C.wave + 16 * cc + r16;
#pragma unroll
            for (int Bq = 0; Bq < 4; ++Bq) {
                f32x4 acc;
#pragma unroll
                for (int rg = 0; rg < 4; ++rg) { const int i = 16 * Bq + 4 * q4 + rg;
                    acc[rg] = (c < 128) ? bf2f(*(const LAS bf16_t*)(vb + i * 272 + c * 2)) * beta[i] : bf2f(*(const LAS bf16_t*)(kb + i * 272 + (c - 128) * 2)) * (beta[i] * eg[i]); }
#pragma unroll
                for (int ks = 0; ks < 4 * Bq; ++ks)
                    acc = __builtin_amdgcn_mfma_f32_16x16x4f32(-mm[(16 * Bq + r16) * 68 + 4 * ks + q4], solL[(4 * ks + q4) * 256 + 32 * C.wave + 16 * cc + r16], acc, 0, 0, 0);
#pragma unroll
                for (int rg = 0; rg < 4; ++rg) solL[(16 * Bq + 4 * q4 + rg) * 256 + c] = acc[rg];
                f32x4 sol = {0.f, 0.f, 0.f, 0.f};
#pragma unroll
                for (int ks = 0; ks < 4; ++ks) sol = __builtin_amdgcn_mfma_f32_16x16x4f32(tf[Bq][ks], solL[(16 * Bq + 4 * ks + q4) * 256 + c], sol, 0, 0, 0);
#pragma unroll
                for (int rg = 0; rg < 4; ++rg) { const int i = 16 * Bq + 4 * q4 + rg; solL[i * 256 + c] = sol[rg];
                    if (c < 128) Ug[(c >> 4) * 1024 + i * 16 + (c & 15)] = f2bf(sol[rg]); else Wg[i * 128 + (c - 128)] = f2bf(-sol[rg]); }
            }
        }
    }
    GA_BAR();
    if (L.tid < 256) { const int c = L.tid; const float sg = (c < 128) ? 1.0f : -1.0f;
#pragma unroll
        for (int t8 = 0; t8 < 8; ++t8) { u32x4 o;
            o.x = pk2(sg * solL[(8 * t8 + 0) * 256 + c], sg * solL[(8 * t8 + 1) * 256 + c]); o.y = pk2(sg * solL[(8 * t8 + 2) * 256 + c], sg * solL[(8 * t8 + 3) * 256 + c]);
            o.z = pk2(sg * solL[(8 * t8 + 4) * 256 + c], sg * solL[(8 * t8 + 5) * 256 + c]); o.w = pk2(sg * solL[(8 * t8 + 6) * 256 + c], sg * solL[(8 * t8 + 7) * 256 + c]);
            *(LAS u32x4*)(uwt + c * 144 + t8 * 16) = o; } }
    GA_BAR0();
    {
        const int r16 = L.lane & 15, q4 = L.lane >> 4; const float gl = gc[63];
        bf16x8 kf[8][2];
#pragma unroll
        for (int ks = 0; ks < 2; ++ks) { float dk[8];
#pragma unroll
            for (int j = 0; j < 8; ++j) dk[j] = __expf(gl - gc[32 * ks + 8 * q4 + j]);
#pragma unroll
            for (int Td = 0; Td < 8; ++Td) { float x[8];
#pragma unroll
                for (int j = 0; j < 8; ++j) x[j] = bf2f(*(const LAS bf16_t*)(kb + (32 * ks + 8 * q4 + j) * 272 + (16 * Td + r16) * 2)) * dk[j];
                u32x4 p; p.x = pk2(x[0], x[1]); p.y = pk2(x[2], x[3]); p.z = pk2(x[4], x[5]); p.w = pk2(x[6], x[7]); kf[Td][ks] = __builtin_bit_cast(bf16x8, p); } }
        const bf16x8 wa0 = *(const LAS bf16x8*)(uwt + (128 + 16 * C.wave + r16) * 144 + q4 * 16), wa1 = *(const LAS bf16x8*)(uwt + (128 + 16 * C.wave + r16) * 144 + 64 + q4 * 16);
        const bf16x8 ub0 = *(const LAS bf16x8*)(uwt + (16 * C.wave + r16) * 144 + q4 * 16), ub1 = *(const LAS bf16x8*)(uwt + (16 * C.wave + r16) * 144 + 64 + q4 * 16);
        bf16_t* GA = (bf16_t*)(C.ws + WS_GA) + (size_t)unit * 16384; bf16_t* GBT = (bf16_t*)(C.ws + WS_GBT) + (size_t)unit * 16384;
#pragma unroll
        for (int Ti = 0; Ti < 8; ++Ti) {
            f32x4 a = {0.f, 0.f, 0.f, 0.f}, bq = {0.f, 0.f, 0.f, 0.f};
            a = mfma16(wa0, kf[Ti][0], a); a = mfma16(wa1, kf[Ti][1], a);
            bq = mfma16(kf[Ti][0], ub0, bq); bq = mfma16(kf[Ti][1], ub1, bq);
            u32x2 oa; oa.x = pk2(a[0], a[1]); oa.y = pk2(a[2], a[3]);
            *(u32x2*)(GA + (size_t)(16 * Ti + r16) * 128 + 16 * C.wave + 4 * q4) = oa;
            u32x2 ob; ob.x = pk2(bq[0], bq[1]); ob.y = pk2(bq[2], bq[3]);
            *(u32x2*)(GBT + (size_t)(16 * C.wave + r16) * 128 + 16 * Ti + 4 * q4) = ob; }
    }
    GA_BAR();
    }
    }
#undef GA_LOAD
#undef GA_BAR
#undef GA_BAR0
    { const int ln = C.lane; CV_DRAIN(cv, ln, cvs); }
    __syncthreads();
}

DI void s5_load_u(const Ctx& C, const bf16_t* up, u32x4& u0, u32x4& u1) { u0 = *(const u32x4*)(up + (size_t)C.lane * EVEN_INP); u1 = *(const u32x4*)(up + (size_t)C.lane * EVEN_INP + 8); }
DI void s5_put_u(const Ctx& C, LAS unsigned char* ub, const u32x4 u0, const u32x4 u1) { *(LAS u32x4*)(ub + C.lane * 32) = u0; *(LAS u32x4*)(ub + C.lane * 32 + 16) = u1; }
DI void s5_bfrags(const Ctx& C, const unsigned char* cf, int g, bf16x8 (&bfr)[8]) {
    const int r16 = C.lane & 15, q4 = C.lane >> 4;
#pragma unroll
    for (int Nn = 0; Nn < 8; ++Nn) { const float* src = (const float*)(cf + ((Nn < 4) ? COEF_BBR : COEF_BBI)) + (size_t)(g * 64 + 16 * (Nn & 3) + r16) * 16 + 8 * (q4 & 1);
        const f32x4 x0 = *(const f32x4*)src, x1 = *(const f32x4*)(src + 4); const bf16x8 v = pack8(x0, x1);
        bfr[Nn] = (q4 < 2) ? v : (bf16x8){0, 0, 0, 0, 0, 0, 0, 0}; }
}
DI void s5_bu(const Ctx& C, const LAS unsigned char* ub, int sc, const bf16x8 (&bfr)[8], LAS float* BU) {
    const int r16 = C.lane & 15, q4 = C.lane >> 4;
    const bf16x8 av = *(const LAS bf16x8*)(ub + (16 * sc + r16) * 32 + 16 * (q4 & 1));
    const bf16x8 afr = (q4 < 2) ? av : (bf16x8){0, 0, 0, 0, 0, 0, 0, 0};
#pragma unroll
    for (int Nn = 0; Nn < 8; ++Nn) { const f32x4 a = mfma16(afr, bfr[Nn], (f32x4){0.f, 0.f, 0.f, 0.f});
#pragma unroll
        for (int rg = 0; rg < 4; ++rg) BU[(4 * q4 + rg) * 132 + 16 * Nn + r16] = a[rg]; }
}
DI void s5_local_unit(const Ctx& C, int ie, int uid, LAS unsigned char* wl) {
    const int b = uid >> 9, grp = (uid >> 5) & 15, g = uid & 31, gn = g * 64 + C.lane;
    const unsigned char* cf = C.ws + WS_COEF + (size_t)ie * COEF_BYTES;
    const float ar = ((const float*)(cf + COEF_AR))[gn], ai = ((const float*)(cf + COEF_AI))[gn];
    bf16x8 bfr[8]; s5_bfrags(C, cf, g, bfr);
    LAS float* BU = (LAS float*)(wl + 4096);
    const bf16_t* up = (const bf16_t*)(C.ws + WS_PROJ) + (size_t)(b * SEQ + 256 * grp) * EVEN_INP + 2056 + 16 * g;
    u32x4 u0, u1; s5_load_u(C, up, u0, u1);
    float xr = 0.f, xi = 0.f;
#pragma unroll 1
    for (int ck = 0; ck < 4; ++ck) {
        LAS unsigned char* ub = wl + (ck & 1) * 2048;
        s5_put_u(C, ub, u0, u1);
        if (ck < 3) s5_load_u(C, up + (size_t)(ck + 1) * 64 * EVEN_INP, u0, u1);
#pragma unroll 1
        for (int sc = 0; sc < 4; ++sc) {
            s5_bu(C, ub, sc, bfr, BU);
#pragma unroll
            for (int tt = 0; tt < 16; ++tt) { const float br_ = BU[tt * 132 + C.lane], bi_ = BU[tt * 132 + 64 + C.lane];
                const float nr = ar * xr - ai * xi + br_, ni = ar * xi + ai * xr + bi_; xr = nr; xi = ni; }
        }
    }
    ((f32x2*)(C.ws + WS_S5E))[(size_t)((b * 16 + grp) * 32 + g) * 64 + C.lane] = (f32x2){xr, xi};
    asm volatile("s_waitcnt lgkmcnt(0)" ::: "memory");
}

DI void s5_out_unit(const Ctx& C, int ie, int uid, LAS unsigned char* wl) {
    const int b = uid >> 9, grp = (uid >> 5) & 15, g = uid & 31, gn = g * 64 + C.lane;
    const unsigned char* cf = C.ws + WS_COEF + (size_t)ie * COEF_BYTES;
    const float ar = ((const float*)(cf + COEF_AR))[gn], ai = ((const float*)(cf + COEF_AI))[gn];
    const float a64r = ((const float*)(cf + COEF_A64R))[gn], a64i = ((const float*)(cf + COEF_A64I))[gn];
    bf16x8 bfr[8]; s5_bfrags(C, cf, g, bfr);
    LAS float* BU = (LAS float*)(wl + 4096); LAS unsigned char* Xs = wl + 12544;
    const bf16_t* up = (const bf16_t*)(C.ws + WS_PROJ) + (size_t)(b * SEQ + 256 * grp) * EVEN_INP + 2056 + 16 * g;
    u32x4 u0, u1; s5_load_u(C, up, u0, u1);
    const int r16 = C.lane & 15, q4 = C.lane >> 4;
    bf16x8 cfr[4];
    {   const float* cre = C.in[C.zero + I_ECRE] + (size_t)ie * 32768 + (size_t)g * 1024 + r16 * 64 + 8 * q4; const float* cim = C.in[C.zero + I_ECIM] + (size_t)ie * 32768 + (size_t)g * 1024 + r16 * 64 + 8 * q4;
#pragma unroll
        for (int ks = 0; ks < 2; ++ks) { const f32x4 x0 = *(const f32x4*)(cre + 32 * ks), x1 = *(const f32x4*)(cre + 32 * ks + 4), y0 = *(const f32x4*)(cim + 32 * ks), y1 = *(const f32x4*)(cim + 32 * ks + 4);
            cfr[ks] = pack8(x0, x1); cfr[2 + ks] = pack8(-y0, -y1); } }
    float xr = 0.f, xi = 0.f;
    {   const f32x2* E = (const f32x2*)(C.ws + WS_S5E) + (size_t)(b * 16 * 32 + g) * 64 + C.lane;
        f32x2 e[15];
#pragma unroll
        for (int j = 0; j < 15; ++j) e[j] = (j < grp) ? E[(size_t)j * 32 * 64] : (f32x2){0.f, 0.f};
#pragma unroll
        for (int j = 0; j < 15; ++j) if (j < grp) { const float nr = a64r * xr - a64i * xi + e[j].x, ni = a64r * xi + a64i * xr + e[j].y; xr = nr; xi = ni; } }
    const f32x4 dv = *(const f32x4*)(C.in[C.zero + I_EDSKIP] + (size_t)ie * 512 + 16 * g + 4 * q4);
    bf16_t* GY = (bf16_t*)(C.ws + WS_GY);
#pragma unroll 1
    for (int ck = 0; ck < 4; ++ck) {
        LAS unsigned char* ub = wl + (ck & 1) * 2048;
        s5_put_u(C, ub, u0, u1);
        if (ck < 3) s5_load_u(C, up + (size_t)(ck + 1) * 64 * EVEN_INP, u0, u1);
#pragma unroll 1
        for (int sc = 0; sc < 4; ++sc) {
            s5_bu(C, ub, sc, bfr, BU);
#pragma unroll
            for (int tt = 0; tt < 16; ++tt) { const float br_ = BU[tt * 132 + C.lane], bi_ = BU[tt * 132 + 64 + C.lane];
                const float nr = ar * xr - ai * xi + br_, ni = ar * xi + ai * xr + bi_; xr = nr; xi = ni;
                *(LAS bf16_t*)(Xs + tt * 272 + C.lane * 2) = f2bf(xr); *(LAS bf16_t*)(Xs + tt * 272 + (64 + C.lane) * 2) = f2bf(xi); }
            f32x4 y = {0.f, 0.f, 0.f, 0.f};
#pragma unroll
            for (int ks = 0; ks < 4; ++ks) y = mfma16(cfr[ks], *(const LAS bf16x8*)(Xs + r16 * 272 + ks * 64 + q4 * 16), y);
            const int t = 16 * sc + r16;
            const u32x2 uu = *(const LAS u32x2*)(ub + t * 32 + 8 * q4);
            y = y + dv * (f32x4){bflo(uu.x), bfhi(uu.x), bflo(uu.y), bfhi(uu.y)};
#pragma unroll
            for (int j = 0; j < 4; ++j) y[j] = 0.5f * y[j] * (1.0f + erff(y[j] * 0.70710678118654752f));
            u32x2 o; o.x = pk2(y[0], y[1]); o.y = pk2(y[2], y[3]);
            *(u32x2*)(GY + (size_t)(b * SEQ + 256 * grp + 64 * ck + t) * 512 + 16 * g + 4 * q4) = o;
        }
    }
    asm volatile("s_waitcnt lgkmcnt(0)" ::: "memory");
}

DI void gdn_b_chain(const Ctx& C, int chain) {
    constexpr int BUF = 39168;
    const int bh = chain >> 3, sl = chain & 7;
    const int ub = bh * 64;
    const bf16_t* GA = (const bf16_t*)(C.ws + WS_GA); const bf16_t* GBT = (const bf16_t*)(C.ws + WS_GBT); const float* GL = (const float*)(C.ws + WS_GL);
    bf16_t* GST = (bf16_t*)(C.ws + WS_GST);
    u32x4 r0[5], r1[5], r2[5];
#define GB_LOAD(R, nn) do { const size_t un = (size_t)(ub + (nn)); \
        _Pragma("unroll") for (int i_ = 0; i_ < 4; ++i_) R[i_] = *(const u32x4*)(GA + un * 16384 + (size_t)(C.tid + 512 * i_) * 8); \
        if (C.tid < 256) R[4] = *(const u32x4*)(GBT + un * 16384 + (size_t)sl * 2048 + (size_t)C.tid * 8); } while (0)
#define GB_STORE(R, bufi) do { LAS unsigned char* B_ = C.lds + (bufi) * BUF; \
        _Pragma("unroll") for (int i_ = 0; i_ < 4; ++i_) { const int p = C.tid + 512 * i_; *(LAS u32x4*)(B_ + (p >> 4) * 272 + (p & 15) * 16) = R[i_]; } \
        if (C.tid < 256) *(LAS u32x4*)(B_ + 34816 + (C.tid >> 4) * 272 + (C.tid & 15) * 16) = R[4]; } while (0)
    f32x4 S[8];
#pragma unroll
    for (int i = 0; i < 8; ++i) S[i] = (f32x4){0.f, 0.f, 0.f, 0.f};
    const int r16 = C.lane & 15, q4 = C.lane >> 4;
    const float glv = GL[ub + C.lane];
#define GB_AF(af_, pr_) do { _Pragma("unroll") for (int h_ = 0; h_ < 2; ++h_) _Pragma("unroll") for (int s = 0; s < 4; ++s) { const LAS unsigned char* p = Bf + (16 * (2 * (pr_) + h_) + r16) * 272 + (32 * s + 4 * q4) * 2; \
        af_[4 * h_ + s] = join8(*(const LAS s16x4*)p, *(const LAS s16x4*)(p + 32)); } } while (0)
#define GB_STEP(n, RL, RS) do { \
        if ((n) + 3 < 64) GB_LOAD(RL, (n) + 3); \
        if (C.wave == 0) { \
            const LAS unsigned char* Bf = C.lds + ((n) & 1) * BUF; \
            bf16_t* stp = GST + (size_t)(ub + (n)) * 16384 + (size_t)(sl * 16 + r16) * 128 + 4 * q4; \
            bf16x8 Sb[4]; \
            _Pragma("unroll") for (int s = 0; s < 4; ++s) Sb[s] = pack8(S[2 * s], S[2 * s + 1]); \
            _Pragma("unroll") for (int s = 0; s < 4; ++s) { const u32x4 pk = __builtin_bit_cast(u32x4, Sb[s]); \
                *(u32x2*)(stp + 32 * s) = (u32x2){pk.x, pk.y}; *(u32x2*)(stp + 32 * s + 16) = (u32x2){pk.z, pk.w}; } \
            const float gl = __int_as_float(__builtin_amdgcn_readlane(__float_as_int(glv), (n))); \
            _Pragma("unroll") for (int pr = 0; pr < 4; ++pr) { \
                bf16x8 afA_[8]; GB_AF(afA_, pr); \
                const int Td0 = 2 * pr; \
                const u32x2 bi0 = *(const LAS u32x2*)(Bf + 34816 + r16 * 272 + (16 * Td0 + 4 * q4) * 2), bi1 = *(const LAS u32x2*)(Bf + 34816 + r16 * 272 + (16 * Td0 + 16 + 4 * q4) * 2); \
                __builtin_amdgcn_sched_barrier(0); \
                f32x4 a0 = S[Td0] * gl + (f32x4){bflo(bi0.x), bfhi(bi0.x), bflo(bi0.y), bfhi(bi0.y)}, a1 = S[Td0 + 1] * gl + (f32x4){bflo(bi1.x), bfhi(bi1.x), bflo(bi1.y), bfhi(bi1.y)}; \
                _Pragma("unroll") for (int s = 0; s < 4; ++s) { a0 = mfma16(afA_[s], Sb[s], a0); a1 = mfma16(afA_[4 + s], Sb[s], a1); } \
                S[Td0] = a0; S[Td0 + 1] = a1; } \
        } \
        if ((n) + 1 < 64) GB_STORE(RS, ((n) + 1) & 1); \
        __syncthreads(); } while (0)
    GB_LOAD(r0, 0); GB_STORE(r0, 0);
    GB_LOAD(r1, 1); GB_LOAD(r2, 2);
    __syncthreads();
#pragma unroll 1
    for (int n0 = 0; n0 < 60; n0 += 6) {
        GB_STEP(n0 + 0, r0, r1); GB_STEP(n0 + 1, r1, r2); GB_STEP(n0 + 2, r2, r0);
        GB_STEP(n0 + 3, r0, r1); GB_STEP(n0 + 4, r1, r2); GB_STEP(n0 + 5, r2, r0);
    }
    GB_STEP(60, r0, r1); GB_STEP(61, r1, r2); GB_STEP(62, r2, r0); GB_STEP(63, r0, r1);
#undef GB_LOAD
#undef GB_STORE
#undef GB_STEP
#undef GB_AF
}

DI void gdn_c_phase(const Ctx& C, int ie) {
    if (C.bid >= 1024) return;
    const int h = (C.bid >> 6) & 3;
    LAS unsigned char* L = C.lds; LAS float* red = (LAS float*)(C.lds + 95232);
    const bf16_t* PROJ = (const bf16_t*)(C.ws + WS_PROJ); bf16_t* CAT = (bf16_t*)(C.ws + WS_CAT);
    u32x4 st[13];
#define GC_LOAD(un, TID) do { const size_t u_ = (size_t)(un); const int b_ = (un) >> 8, n_ = (un) & 63; \
        const bf16_t* GWN = (const bf16_t*)(C.ws + WS_GWN) + u_ * 8192; const bf16_t* GQG = (const bf16_t*)(C.ws + WS_GQG) + u_ * 8192; \
        const bf16_t* GQK = (const bf16_t*)(C.ws + WS_GQK) + u_ * 4096; const bf16_t* GU = (const bf16_t*)(C.ws + WS_GU) + u_ * 8192; const bf16_t* GST = (const bf16_t*)(C.ws + WS_GST) + u_ * 16384; \
        _Pragma("unroll") for (int i = 0; i < 2; ++i) { const int p = (TID) + 512 * i; st[i] = *(const u32x4*)(GWN + (size_t)p * 8); st[2 + i] = *(const u32x4*)(GQG + (size_t)p * 8); st[9 + i] = *(const u32x4*)(GU + (size_t)p * 8); \
            st[11 + i] = *(const u32x4*)(PROJ + (size_t)(b_ * SEQ + n_ * 64 + (p >> 4)) * EVEN_INP + 1536 + h * 128 + (p & 15) * 8); } \
        st[4] = *(const u32x4*)(GQK + (size_t)(TID) * 8); \
        _Pragma("unroll") for (int i = 0; i < 4; ++i) st[5 + i] = *(const u32x4*)(GST + (size_t)((TID) + 512 * i) * 8); } while (0)
    GC_LOAD(C.bid, C.tid);
    const float gw = C.in[C.zero + I_EGNW][(size_t)ie * 128 + C.wave * 16 + (C.lane & 15)];
#pragma unroll 1
    for (int unit = C.bid; unit < 1024; unit += C.G) {
        Ctx Lc; Lc.tid = opv_(C.tid); Lc.lane = Lc.tid & 63;
        const int b = unit >> 8, n = unit & 63;
#pragma unroll
        for (int i = 0; i < 2; ++i) { const int p = Lc.tid + 512 * i; *(LAS u32x4*)(L + (p >> 4) * 272 + (p & 15) * 16) = st[i]; *(LAS u32x4*)(L + 17408 + (p >> 4) * 272 + (p & 15) * 16) = st[2 + i];
            *(LAS u32x4*)(L + 78848 + p * 16) = st[9 + i]; *(LAS u32x4*)(L + 97280 + (p >> 4) * 272 + (p & 15) * 16) = st[11 + i]; }
        *(LAS u32x4*)(L + 34816 + (Lc.tid >> 3) * 144 + (Lc.tid & 7) * 16) = st[4];
#pragma unroll
        for (int i = 0; i < 4; ++i) { const int p = Lc.tid + 512 * i; *(LAS u32x4*)(L + 44032 + (p >> 4) * 272 + (p & 15) * 16) = st[5 + i]; }
        __syncthreads();
        if (unit + C.G < 1024) GC_LOAD(unit + C.G, Lc.tid);
        const int sl = C.wave, r16 = Lc.lane & 15, q4 = Lc.lane >> 4;
        bf16x8 Sb[4];
#pragma unroll
        for (int s = 0; s < 4; ++s) { const LAS unsigned char* p = L + 44032 + (16 * sl + r16) * 272 + (32 * s + 4 * q4) * 2; Sb[s] = join8(*(const LAS s16x4*)p, *(const LAS s16x4*)(p + 32)); }
        f32x4 vn[4], o[4];
#pragma unroll
        for (int T = 0; T < 4; ++T) {
            bf16x8 aw[4], aq[4];
#pragma unroll
            for (int s = 0; s < 4; ++s) { const LAS unsigned char* p = L + (16 * T + r16) * 272 + (32 * s + 4 * q4) * 2;
                aw[s] = join8(*(const LAS s16x4*)p, *(const LAS s16x4*)(p + 32)); aq[s] = join8(*(const LAS s16x4*)(p + 17408), *(const LAS s16x4*)(p + 17408 + 32)); }
#pragma unroll
            for (int rg = 0; rg < 4; ++rg) vn[T][rg] = bf2f(*(const LAS bf16_t*)(L + 78848 + sl * 2048 + (16 * T + 4 * q4 + rg) * 32 + r16 * 2));
            o[T] = (f32x4){0.f, 0.f, 0.f, 0.f};
#pragma unroll
            for (int s = 0; s < 4; ++s) { vn[T] = mfma16(aw[s], Sb[s], vn[T]); o[T] = mfma16(aq[s], Sb[s], o[T]); } }
        bf16x8 Vb[2];
#pragma unroll
        for (int s = 0; s < 2; ++s) Vb[s] = pack8(vn[2 * s], vn[2 * s + 1]);
#pragma unroll
        for (int T = 0; T < 4; ++T)
#pragma unroll
            for (int s = 0; s < 2; ++s) { const LAS unsigned char* p = L + 34816 + (16 * T + r16) * 144 + (32 * s + 4 * q4) * 2;
                o[T] = mfma16(join8(*(const LAS s16x4*)p, *(const LAS s16x4*)(p + 32)), Vb[s], o[T]); }
#pragma unroll
        for (int T = 0; T < 4; ++T)
#pragma unroll
            for (int rg = 0; rg < 4; ++rg) { const float ss = row16_sum(o[T][rg] * o[T][rg]); if (r16 == 0) red[C.wave * 64 + 16 * T + 4 * q4 + rg] = ss; }
        __syncthreads();
#pragma unroll
        for (int T = 0; T < 4; ++T)
#pragma unroll
            for (int rg = 0; rg < 4; ++rg) { const int t = 16 * T + 4 * q4 + rg; float tot = 0.f;
#pragma unroll
                for (int w = 0; w < 8; ++w) tot += red[w * 64 + t];
                const float rs = 1.0f / sqrtf(tot * (1.0f / 128.0f) + 1e-6f);
                const float z = bf2f(*(const LAS bf16_t*)(L + 97280 + t * 272 + (sl * 16 + r16) * 2));
                *(LAS bf16_t*)(L + 114688 + t * 272 + (sl * 16 + r16) * 2) = f2bf(o[T][rg] * rs * gw * silu_f(z)); }
        __syncthreads();
#pragma unroll
        for (int i = 0; i < 2; ++i) { const int p = Lc.tid + 512 * i;
            *(u32x4*)(CAT + (size_t)(b * SEQ + n * 64 + (p >> 4)) * D + h * 128 + (p & 15) * 8) = *(const LAS u32x4*)(L + 114688 + (p >> 4) * 272 + (p & 15) * 16); }
        __syncthreads();
    }
#undef GC_LOAD
}


DI int crow32(int reg, int hh) { return (reg & 3) + 8 * (reg >> 2) + 4 * hh; }
DI void attn_block(const Ctx& C, int io, int b, int h, int jq, float lam, float smax_l2, float post) {
    const int Lt = opv_(C.tid), Ll = Lt & 63;
    constexpr int TB = 34816;
    const bf16_t* QN = (const bf16_t*)(C.ws + WS_QN); const bf16_t* KN = (const bf16_t*)(C.ws + WS_KN); const bf16_t* VT = (const bf16_t*)(C.ws + WS_VT);
    bf16_t* OUT = (bf16_t*)(C.ws + WS_CAT);
    LAS float* Ls = (LAS float*)(C.lds + 139264); LAS float* EX = (LAS float*)(C.lds);
    const int t = C.wave & 1, rg = C.wave >> 1, r = Ll & 31, hh = Ll >> 5;
    const int qrow0 = b * SEQ + 128 * jq + 32 * rg;
    bf16x8 Qf[4];
#pragma unroll
    for (int s = 0; s < 4; ++s) Qf[s] = *(const bf16x8*)(QN + (size_t)(qrow0 + r) * D + h * 128 + t * 64 + 16 * s + 8 * hh);
    f32x16 O[4];
#pragma unroll
    for (int ne = 0; ne < 4; ++ne)
#pragma unroll
        for (int i = 0; i < 16; ++i) O[ne][i] = 0.f;
    float lsum = 0.f;
    const int nkt = 2 * jq + 2;
    const int nact = (rg < 2) ? nkt - 1 : nkt;
    u32x4 sk[2], sv[2];
#define AT_LOAD(kt) do { const size_t krow = (size_t)(b * SEQ + 64 * (kt)); \
        _Pragma("unroll") for (int i_ = 0; i_ < 2; ++i_) { const int p = Lt + 512 * i_; \
            sk[i_] = *(const u32x4*)(KN + (krow + (p >> 4)) * D + h * 128 + (p & 15) * 8); \
            sv[i_] = *(const u32x4*)(VT + (size_t)(h * 128 + (p >> 3)) * M + krow + (p & 7) * 8); } } while (0)
#define AT_STORE(bi) do { LAS unsigned char* B_ = C.lds + (bi) * TB; _Pragma("unroll") for (int i_ = 0; i_ < 2; ++i_) { const int p = Lt + 512 * i_; \
            *(LAS u32x4*)(B_ + (p >> 4) * 272 + (p & 15) * 16) = sk[i_]; \
            *(LAS u32x2*)(B_ + 17408 + (p >> 3) * 136 + (p & 7) * 16) = (u32x2){sv[i_].x, sv[i_].y}; *(LAS u32x2*)(B_ + 17408 + (p >> 3) * 136 + (p & 7) * 16 + 8) = (u32x2){sv[i_].z, sv[i_].w}; } } while (0)
#define AT_QK(Xd, bi) do { const LAS unsigned char* Kb_ = C.lds + (bi) * TB + r * 272 + (t * 64 + 8 * hh) * 2; \
        _Pragma("unroll") for (int kb = 0; kb < 2; ++kb) { bf16x8 kf_[4]; \
            _Pragma("unroll") for (int s = 0; s < 4; ++s) kf_[s] = *(const LAS bf16x8*)(Kb_ + kb * 32 * 272 + s * 32); \
            __builtin_amdgcn_sched_barrier(0); \
            _Pragma("unroll") for (int i = 0; i < 16; ++i) Xd[kb][i] = -smax_l2; \
            _Pragma("unroll") for (int s = 0; s < 4; ++s) Xd[kb] = mfma32(kf_[s], Qf[s], Xd[kb]); } } while (0)
#define AT_EXP(Xk, Pf) do { _Pragma("unroll") for (int i = 0; i < 16; ++i) { const float p = __builtin_amdgcn_exp2f(Xk[i]); Xk[i] = p; lsum += p; } \
        _Pragma("unroll") for (int s = 0; s < 2; ++s) { u32x4 pk; pk.x = pk2(Xk[8 * s], Xk[8 * s + 1]); pk.y = pk2(Xk[8 * s + 2], Xk[8 * s + 3]); \
            pk.z = pk2(Xk[8 * s + 4], Xk[8 * s + 5]); pk.w = pk2(Xk[8 * s + 6], Xk[8 * s + 7]); Pf[s] = __builtin_bit_cast(bf16x8, pk); } } while (0)
#define AT_PV(Vb_, kb, Pf) do { _Pragma("unroll") for (int s = 0; s < 2; ++s) { bf16x8 vf_[4]; \
        _Pragma("unroll") for (int ne = 0; ne < 4; ++ne) { const LAS unsigned char* p = (Vb_) + ne * 32 * 136 + (32 * (kb) + 16 * s) * 2; \
            vf_[ne] = join8(*(const LAS s16x4*)p, *(const LAS s16x4*)(p + 16)); } \
        __builtin_amdgcn_sched_barrier(0); \
        _Pragma("unroll") for (int ne = 0; ne < 4; ++ne) O[ne] = mfma32(Pf[s], vf_[ne], O[ne]); } } while (0)
#define AT_STAGE(kt) do { if ((kt) + 2 < nkt) AT_STORE(((kt) + 2) & 3); if ((kt) + 3 < nkt) AT_LOAD((kt) + 3); } while (0)
    AT_LOAD(0); AT_STORE(0);
    AT_LOAD(1); AT_STORE(1);
    if (nkt > 2) AT_LOAD(2);
    __syncthreads();
    bf16x8 P0[2], P1[2];
#pragma unroll
    for (int s = 0; s < 2; ++s) { P0[s] = (bf16x8){0, 0, 0, 0, 0, 0, 0, 0}; P1[s] = P0[s]; }
    if (C.wave < 4) {
#pragma unroll 1
        for (int kt = 0; kt <= nkt; ++kt) {
            AT_STAGE(kt);
            if (kt < nact) {
                f32x16 X[2];
                const LAS unsigned char* Vp = C.lds + (kt & 3) * TB + 17408 + r * 136 + 8 * hh;
                AT_QK(X, kt & 3);
                AT_EXP(X[0], P0); AT_PV(Vp, 0, P0);
                AT_EXP(X[1], P1); AT_PV(Vp, 1, P1);
            }
            __syncthreads();
        }
    } else {
#pragma unroll 1
        for (int kt = 0; kt <= nkt; ++kt) {
            AT_STAGE(kt);
            f32x16 X[2];
            const bool doqk = kt < nact, dopv = (kt >= 1) && (kt - 1 < nact);
            const LAS unsigned char* Vp = C.lds + ((kt + 3) & 3) * TB + 17408 + r * 136 + 8 * hh;
            if (dopv) { AT_PV(Vp, 0, P0); AT_PV(Vp, 1, P1); }
            if (doqk) { AT_QK(X, kt & 3); AT_EXP(X[0], P0); AT_EXP(X[1], P1); }
            __syncthreads();
        }
    }
#undef AT_STAGE
#undef AT_LOAD
#undef AT_STORE
#undef AT_QK
#undef AT_EXP
#undef AT_PV
    lsum += __shfl_xor(lsum, 32);
    if (Ll < 32) Ls[C.wave * 32 + Ll] = lsum;
    __syncthreads();
    float linv[16];
#pragma unroll
    for (int i = 0; i < 16; ++i) linv[i] = 1.0f / Ls[C.wave * 32 + crow32(i, hh)];
    if (t == 1) {
#pragma unroll
        for (int ne = 0; ne < 4; ++ne)
#pragma unroll
            for (int i = 0; i < 16; ++i) EX[(rg * 32 + crow32(i, hh)) * 132 + 32 * ne + r] = O[ne][i] * linv[i] * lam;
    }
    __syncthreads();
    if (t == 0) {
        float ss[16];
#pragma unroll
        for (int i = 0; i < 16; ++i) ss[i] = 0.f;
#pragma unroll
        for (int ne = 0; ne < 4; ++ne)
#pragma unroll
            for (int i = 0; i < 16; ++i) { const float o = O[ne][i] * linv[i] - EX[(rg * 32 + crow32(i, hh)) * 132 + 32 * ne + r]; O[ne][i] = o; ss[i] += o * o; }
#pragma unroll
        for (int i = 0; i < 16; ++i) { float s = ss[i]; s += __shfl_xor(s, 1); s += __shfl_xor(s, 2); s += __shfl_xor(s, 4); s += __shfl_xor(s, 8); s += __shfl_xor(s, 16);
            ss[i] = (1.0f / sqrtf(s * (1.0f / 128.0f) + 1e-6f)) * post; }
        const float* sw = C.in[C.zero + I_OSUBLN] + (size_t)io * 128;
#pragma unroll
        for (int ne = 0; ne < 4; ++ne) { const float w = sw[32 * ne + r];
#pragma unroll
            for (int i = 0; i < 16; ++i) OUT[(size_t)(qrow0 + crow32(i, hh)) * D + h * 128 + 32 * ne + r] = f2bf(O[ne][i] * ss[i] * w); }
    }
    __syncthreads();
}
DI void attn_phase(const Ctx& C, int io, int layer) {
    const float* lq1 = C.in[C.zero + I_OLQ1] + io * 64; const float* lk1 = C.in[C.zero + I_OLK1] + io * 64; const float* lq2 = C.in[C.zero + I_OLQ2] + io * 64; const float* lk2 = C.in[C.zero + I_OLK2] + io * 64;
    const float s1 = wave_sum(lq1[C.lane] * lk1[C.lane]), s2 = wave_sum(lq2[C.lane] * lk2[C.lane]);
    const float lambda_init = 0.8f - 0.6f * expf(-0.3f * (float)layer);
    const float lam = expf(s1) - expf(s2) + lambda_init;
    const float mq = wave_max(fabsf(C.in[C.zero + I_OQNW][io * 64 + C.lane])), mk = wave_max(fabsf(C.in[C.zero + I_OKNW][io * 64 + C.lane]));
    const float smax_l2 = 8.0f * mq * mk * 1.02f * 1.4426950408889634f;
    for (int up = C.bid; up < 512; up += C.G) {
        const int bh = up >> 4, jp = up & 15;
        attn_block(C, io, bh >> 3, bh & 7, jp, lam, smax_l2, 1.0f - lambda_init);
        attn_block(C, io, bh >> 3, bh & 7, 31 - jp, lam, smax_l2, 1.0f - lambda_init);
    }
}
template <class T> DI T* opq(T* p) { const unsigned long long u = (unsigned long long)p; unsigned lo = (unsigned)u, hi = (unsigned)(u >> 32); asm volatile("" : "+v"(lo), "+v"(hi));
    lo = __builtin_amdgcn_readfirstlane(lo); hi = __builtin_amdgcn_readfirstlane(hi); return (T*)(((unsigned long long)hi << 32) | lo); }
DI int opv(int x) { asm volatile("" : "+v"(x)); return x; }
DI int ops(int x) { asm volatile("" : "+v"(x)); return __builtin_amdgcn_readfirstlane(x); }
#define SITE_CTX() Ctx K; K.lds = C.lds; K.tid = opv(C.tid); K.lane = K.tid & 63; K.wave = __builtin_amdgcn_readfirstlane(K.tid >> 6); K.G = ops(C.G); K.bid = ops(C.bid); K.zero = ops(0); \
    K.out = C.out + K.zero; K.ws = C.ws + K.zero; K.in = C.in; unsigned char* ws = K.ws; const float* const* inp = K.in; float* XS = K.out; float* MOD = (float*)(ws + WS_MOD); bf16_t* XB = (bf16_t*)(ws + WS_XB); (void)XB; bf16_t* Hb = (bf16_t*)(ws + WS_H); (void)inp; (void)XS; (void)MOD; (void)Hb;
#ifndef SITE_MASK
#define SITE_MASK 0xFFFFFFFFu
#endif
#define INS(j, k) ((((SITE_MASK) >> (j)) & 1u) && lo <= (k) && (k) < hi)
#define IN(k) (lo <= (k) && (k) < hi)
#ifndef REPEAT_MASK
#define REPEAT_MASK 0u
#endif
#ifndef REPN
#define REPN 2
#endif
#define NREP(j) ((((REPEAT_MASK) >> (j)) & 1u) ? REPN : 1)
#define SEAM(k) do { if (IN(k) && IN((k) + 1)) xcd_barrier(bar); } while (0)
template <int lp>
DI void layer_pair(const Ctx& C, const XcdBarrier& bar, const int lo, const int hi) {
        const int base = 1 + 17 * lp, le = 2 * lp, lod = 2 * lp + 1;
        if (INS(1, base + 0)) { for (int rep_ = 0; rep_ < NREP(1); ++rep_) { SITE_CTX();
            const float* modE = MOD + (size_t)le * 4 * 6144;
            if (lp == 0) norm_phase<false, true, false, true>(K, inp[K.zero + I_X], nullptr, inp[K.zero + I_NMIX] + (size_t)le * D, modE, 1024, 0, Hb, nullptr, nullptr, nullptr, nullptr, nullptr, nullptr, nullptr, nullptr);
            else norm_phase<true, true, false, false>(K, XB, XB, inp[K.zero + I_NMIX] + (size_t)le * D, modE, 1024, 0, Hb, (const Route*)(ws + WS_ROUTE), (const bf16_t*)(ws + WS_FS), MOD + (size_t)(le - 1) * 4 * 6144 + 5120, (const unsigned*)(ws + WS_CTL + CW_CNT), nullptr, nullptr, nullptr, nullptr);
        } }
        SEAM(base + 0);
        if (INS(2, base + 1)) { for (int rep_ = 0; rep_ < NREP(2); ++rep_) { SITE_CTX();
            pg8::Gemm g{Hb, (const bf16_t*)(ws + WS_WIN + (size_t)lp * SZ_WIN), M, EVEN_INP, D}; pg8::StaticOrder S; S.init(M, EVEN_INP, K.G, K.bid);
            pg8::EpiProj E{(bf16_t*)(ws + WS_PROJ), (float*)(ws + WS_AB)};
            pg8::gemm_phase(K.lds, K.tid, g, S, E);
        } }
        SEAM(base + 1);
#define SITE3_BODY { SITE_CTX(); \
            gdn_a_phase(K, lp); \
            for (int u = K.bid * NWAVES + K.wave; u < 2048; u += K.G * NWAVES) s5_local_unit(K, lp, u, K.lds + K.wave * 16896); }
        if (INS(3, base + 2)) { SITE3_BODY
#if defined(REP3)
            __syncthreads(); SITE3_BODY
#endif
        }
        SEAM(base + 2);
        if (INS(4, base + 3)) { for (int rep_ = 0; rep_ < NREP(4); ++rep_) { SITE_CTX();
            if (K.G > 128) {
                if (K.bid < 128) { gdn_b_chain(K, K.bid);
#if defined(REP_GDNB)
                    __syncthreads(); gdn_b_chain(K, K.bid);
#endif
                }
                else { for (int u = (K.bid - 128) * NWAVES + K.wave; u < 2048; u += (K.G - 128) * NWAVES) s5_out_unit(K, lp, u, K.lds + K.wave * 16896);
#if defined(REP_S5OUT)
                    for (int u = (K.bid - 128) * NWAVES + K.wave; u < 2048; u += (K.G - 128) * NWAVES) s5_out_unit(K, lp, u, K.lds + K.wave * 16896);
#endif
                }
            } else {
                for (int ch = K.bid; ch < 128; ch += K.G) gdn_b_chain(K, ch);
                for (int u = K.bid * NWAVES + K.wave; u < 2048; u += K.G * NWAVES) s5_out_unit(K, lp, u, K.lds + K.wave * 16896);
            }
        } }
        SEAM(base + 3);
        if (INS(5, base + 4)) { for (int rep_ = 0; rep_ < NREP(5); ++rep_) { SITE_CTX();
            gdn_c_phase(K, lp);
            pg8::Gemm g{(const bf16_t*)(ws + WS_GY), (const bf16_t*)(ws + WS_GLU + (size_t)lp * SZ_GLU), M, 1024, 512}; pg8::StaticOrder S; S.init(M, 1024, K.G, K.bid);
            pg8::EpiGLU E{(bf16_t*)(ws + WS_CAT), inp[K.zero + I_EGLUB] + (size_t)lp * 1024};
            pg8::gemm_phase(K.lds, K.tid, g, S, E);
        } }
        SEAM(base + 4);
        if (INS(6, base + 5)) { for (int rep_ = 0; rep_ < NREP(6); ++rep_) { SITE_CTX();
            pg8::Gemm g{(const bf16_t*)(ws + WS_CAT), (const bf16_t*)(ws + WS_WOE + (size_t)lp * SZ_SQ), M, D, D}; pg8::StaticOrder S; S.init(M, D, K.G, K.bid);
            if (lp == 0) { pg8::EpiResidT<true> E{inp[K.zero + I_X], XB, MOD + (size_t)le * 4 * 6144 + 2048}; pg8::gemm_phase(K.lds, K.tid, g, S, E); }
            else { pg8::EpiResidT<false> E{XB, XB, MOD + (size_t)le * 4 * 6144 + 2048}; pg8::gemm_phase(K.lds, K.tid, g, S, E); }
        } }
        SEAM(base + 5);
        if (INS(7, base + 6)) { for (int rep_ = 0; rep_ < NREP(7); ++rep_) { SITE_CTX();
            norm_phase<false, true, false, false>(K, XB, nullptr, inp[K.zero + I_NFFN] + (size_t)le * D, MOD + (size_t)le * 4 * 6144, 4096, 3072, Hb, nullptr, nullptr, nullptr, nullptr, nullptr, nullptr, nullptr, nullptr); } }
        SEAM(base + 6);
        if (INS(8, base + 7)) { for (int rep_ = 0; rep_ < NREP(8); ++rep_) { SITE_CTX();
            pg8::Gemm g{Hb, (const bf16_t*)(ws + WS_W13 + (size_t)lp * SZ_W13), M, 2 * FF, D}; pg8::StaticOrder S; S.init(M, 2 * FF, K.G, K.bid);
            pg8::EpiSwiGLU E{(bf16_t*)(ws + WS_ACT), FF};
            pg8::gemm_phase(K.lds, K.tid, g, S, E);
        } }
        SEAM(base + 7);
        if (INS(9, base + 8)) { for (int rep_ = 0; rep_ < NREP(9); ++rep_) { SITE_CTX();
            pg8::Gemm g{(const bf16_t*)(ws + WS_ACT), (const bf16_t*)(ws + WS_W2 + (size_t)lp * SZ_W2), M, D, FF}; pg8::StaticOrder S; S.init(M, D, K.G, K.bid);
            pg8::EpiResidT<false> E{XB, XB, MOD + (size_t)le * 4 * 6144 + 5120};
            pg8::gemm_phase(K.lds, K.tid, g, S, E);
        } }
        SEAM(base + 8);
        if (INS(10, base + 9)) { for (int rep_ = 0; rep_ < NREP(10); ++rep_) { SITE_CTX();
            norm_phase<false, true, false, false>(K, XB, nullptr, inp[K.zero + I_NMIX] + (size_t)lod * D, MOD + (size_t)lod * 4 * 6144, 1024, 0, Hb, nullptr, nullptr, nullptr, nullptr, nullptr, nullptr, nullptr, nullptr); } }
        SEAM(base + 9);
        if (INS(11, base + 10)) { for (int rep_ = 0; rep_ < NREP(11); ++rep_) { SITE_CTX();
            {   pg8::Gemm g{Hb, (const bf16_t*)(ws + WS_WQK + (size_t)lp * SZ_WQK), M, 2048, D}; pg8::StaticOrder S; S.init(M, 2048, K.G, K.bid);
                pg8::EpiQKNorm E{(bf16_t*)(ws + WS_QN), (bf16_t*)(ws + WS_KN), inp[K.zero + I_OQNW] + (size_t)lp * 64, inp[K.zero + I_OKNW] + (size_t)lp * 64};
                pg8::gemm_phase(K.lds, K.tid, g, S, E); }
            {
                pg8::Gemm g{(const bf16_t*)(ws + WS_WV + (size_t)lp * SZ_SQ), Hb, D, M, D}; pg8::StaticOrder S; S.init(D, M, K.G, K.bid);
                pg8::EpiBf16Plain E{(bf16_t*)(ws + WS_VT), M};
                pg8::gemm_phase(K.lds, K.tid, g, S, E); }
        } }
        SEAM(base + 10);
        if (INS(12, base + 11)) { for (int rep_ = 0; rep_ < NREP(12); ++rep_) { SITE_CTX(); attn_phase(K, lp, lod); } }
        SEAM(base + 11);
        if (INS(13, base + 12)) { for (int rep_ = 0; rep_ < NREP(13); ++rep_) { SITE_CTX();
            pg8::Gemm g{(const bf16_t*)(ws + WS_CAT), (const bf16_t*)(ws + WS_WOO + (size_t)lp * SZ_SQ), M, D, D}; pg8::StaticOrder S; S.init(M, D, K.G, K.bid);
            pg8::EpiResidT<false> E{XB, XB, MOD + (size_t)lod * 4 * 6144 + 2048};
            pg8::gemm_phase(K.lds, K.tid, g, S, E);
        } }
        SEAM(base + 12);
        if (INS(14, base + 13)) { for (int rep_ = 0; rep_ < NREP(14); ++rep_) { SITE_CTX();
            norm_phase<false, true, true, false>(K, XB, nullptr, inp[K.zero + I_NFFN] + (size_t)lod * D, MOD + (size_t)lod * 4 * 6144, 4096, 3072, Hb, nullptr, nullptr, nullptr, nullptr,
                                          inp[K.zero + I_OROUTER] + (size_t)lp * D * 8, (unsigned*)(ws + WS_CTL + CW_CNT) + (size_t)lp * 8 * 64, (Route*)(ws + WS_ROUTE) + (size_t)lp * M, (bf16_t*)(ws + WS_HS)); } }
        SEAM(base + 13);
        if (INS(16, base + 15)) { for (int rep_ = 0; rep_ < NREP(16); ++rep_) { SITE_CTX();
            pg8::Gemm g{(const bf16_t*)(ws + WS_HS), (const bf16_t*)(ws + WS_EW13 + (size_t)lp * SZ_EW13), MS, 2 * FF, D};
            pg8::GroupedOrder S; S.init((const unsigned*)(ws + WS_CTL + CW_CNT) + (size_t)lp * 8 * 64, 2 * FF / 256, K.G, K.bid, 1);
            pg8::EpiSwiGLU E{(bf16_t*)(ws + WS_ACTS), FF};
            pg8::gemm_phase(K.lds, K.tid, g, S, E);
        } }
        SEAM(base + 15);
        if (INS(17, base + 16)) { for (int rep_ = 0; rep_ < NREP(17); ++rep_) { SITE_CTX();
            pg8::Gemm g{(const bf16_t*)(ws + WS_ACTS), (const bf16_t*)(ws + WS_EW2 + (size_t)lp * SZ_EW2), MS, D, FF};
            pg8::GroupedOrder S; S.init((const unsigned*)(ws + WS_CTL + CW_CNT) + (size_t)lp * 8 * 64, D / 256, K.G, K.bid, 0);
            pg8::EpiBf16Plain E{(bf16_t*)(ws + WS_FS), D};
            pg8::gemm_phase(K.lds, K.tid, g, S, E);
        } }
        SEAM(base + 16);
    }
__global__ void __launch_bounds__(NTHR, 2) fwd_kernel(Args args) {
    extern __shared__ __attribute__((aligned(16))) unsigned char lds_raw[];
    Ctx C;
    C.lds = (LAS unsigned char*)lds_raw; C.tid = threadIdx.x; C.lane = C.tid & 63; C.wave = __builtin_amdgcn_readfirstlane(C.tid >> 6);
    C.G = gridDim.x; C.bid = blockIdx.x; C.zero = 0; C.in = args.in; C.out = args.out; C.ws = args.ws;
    volatile LAS unsigned* xbw = (volatile LAS unsigned*)(C.lds + LDS_BYTES - 16);
    if (C.tid == 0) { xbw[0] = 0u; xbw[1] = 0u; xbw[2] = 0u; xbw[3] = 0u; }
    __syncthreads();
    XcdBarrier bar; bar.bar = (unsigned*)(C.ws + WS_CTL); bar.x = 0; bar.st = xbw;
    const int lo = args.ph_lo, hi = args.ph_hi;
    if (hi - lo > 1) bar = xcd_barrier_post((unsigned*)(C.ws + WS_CTL), xbw);

    if (INS(0, 0)) { for (int rep_ = 0; rep_ < NREP(0); ++rep_) p0_prologue(C, args); }
    SEAM(0);

    layer_pair<0>(C, bar, lo, hi);
    layer_pair<1>(C, bar, lo, hi);
    if (INS(18, 35)) { for (int rep_ = 0; rep_ < NREP(18); ++rep_) { SITE_CTX();
        norm_phase<true, false, false, false, true>(K, XB, XS, nullptr, nullptr, 0, 0, nullptr, (const Route*)(ws + WS_ROUTE) + M, (const bf16_t*)(ws + WS_FS), MOD + (size_t)3 * 4 * 6144 + 5120, (const unsigned*)(ws + WS_CTL + CW_CNT) + 8 * 64, nullptr, nullptr, nullptr, nullptr); } }
#undef IN
#undef INS
#undef SEAM
}

static void fill_desc(Args& a, void* const* d_in, unsigned char* ws) {
    int nd = 0, item = 0;
    auto add = [&](const float* src, size_t dst_off, int ld, int K, int N, int Npad, int E, size_t src_es, int dst_erows, int map, int mp) {
        TDesc& t = a.td[nd++]; t.src = src; t.dst = (bf16_t*)(ws + dst_off); t.ld = ld; t.K = K; t.N = N; t.nblk = Npad / 32; t.E = E; t.map = map; t.mp = mp; t.item0 = item;
        t.src_es = src_es; t.dst_erows = dst_erows; t.pad_ = 0; item += E * (K / 64) * (Npad / 32);
    };
    for (int i = 0; i < 2; ++i) {
        add((const float*)d_in[I_EWIN] + (size_t)i * D * EVEN_IN, WS_WIN + i * SZ_WIN, EVEN_IN, D, EVEN_IN, EVEN_INP, 1, 0, 0, 0, 0);
        add((const float*)d_in[I_EGLUW] + (size_t)i * 512 * 1024, WS_GLU + i * SZ_GLU, 1024, 512, 1024, 1024, 1, 0, 0, 1, 512);
        add((const float*)d_in[I_EWOUT] + (size_t)i * D * D, WS_WOE + i * SZ_SQ, D, D, D, D, 1, 0, 0, 0, 0);
        add((const float*)d_in[I_EW13] + (size_t)i * D * 2 * FF, WS_W13 + i * SZ_W13, 2 * FF, D, 2 * FF, 2 * FF, 1, 0, 0, 1, FF);
        add((const float*)d_in[I_EW2] + (size_t)i * FF * D, WS_W2 + i * SZ_W2, D, FF, D, D, 1, 0, 0, 0, 0);
        add((const float*)d_in[I_OWQKV] + (size_t)i * D * 3072, WS_WQK + i * SZ_WQK, 3072, D, 2048, 2048, 1, 0, 0, 2, 0);
        add((const float*)d_in[I_OWQKV] + (size_t)i * D * 3072 + 2048, WS_WV + i * SZ_SQ, 3072, D, 1024, 1024, 1, 0, 0, 0, 0);
        add((const float*)d_in[I_OWOUT] + (size_t)i * D * D, WS_WOO + i * SZ_SQ, D, D, D, D, 1, 0, 0, 0, 0);
        add((const float*)d_in[I_OEW13] + (size_t)i * NEXP * D * 2 * FF, WS_EW13 + i * SZ_EW13, 2 * FF, D, 2 * FF, 2 * FF, NEXP, (size_t)D * 2 * FF, 2 * FF, 1, FF);
        add((const float*)d_in[I_OEW2] + (size_t)i * NEXP * FF * D, WS_EW2 + i * SZ_EW2, D, FF, D, D, NEXP, (size_t)FF * D, D, 0, 0);
    }
    a.n_items = item;
    a.n_pro = a.td[5].item0;
    a.cv_lo[0] = a.n_pro; a.cv_hi[0] = a.td[18].item0;
    a.cv_lo[1] = a.td[18].item0; a.cv_hi[1] = item;
}

#ifndef MK_N_LAUNCHES
#define MK_N_LAUNCHES 1
#endif

extern "C" void kernel_launch(void* const* d_in, const int* in_sizes, int n_in, void* d_out, int out_size, void* d_ws, size_t ws_size, hipStream_t stream) {
    static int grid = 0;
    if (grid == 0) {
        if (n_in != N_IN || out_size != M * D || ws_size < WS_END) { fprintf(stderr, "kernel_launch: unexpected problem: n_in %d out %d ws %zu (need %zu)\n", n_in, out_size, ws_size, (size_t)WS_END); grid = -1; return; }
        int dev = 0, cus = 0, per_cu = 0;
        if (hipGetDevice(&dev) != hipSuccess || hipDeviceGetAttribute(&cus, hipDeviceAttributeMultiprocessorCount, dev) != hipSuccess) { grid = -1; return; }
        if (hipFuncSetAttribute((const void*)fwd_kernel, hipFuncAttributeMaxDynamicSharedMemorySize, LDS_BYTES) != hipSuccess) { fprintf(stderr, "kernel_launch: hipFuncSetAttribute failed\n"); grid = -1; return; }
        if (hipOccupancyMaxActiveBlocksPerMultiprocessor(&per_cu, (const void*)fwd_kernel, NTHR, LDS_BYTES) != hipSuccess || per_cu < 1) { fprintf(stderr, "kernel_launch: occupancy query says %d\n", per_cu); }
        (void)hipGetLastError();
        grid = cus;
    }
    if (grid < 0) return;
    (void)hipMemsetAsync((char*)d_ws + WS_CTL, 0, CTL_BYTES, stream);
    Args a; memset(&a, 0, sizeof(a));
    for (int i = 0; i < N_IN; ++i) a.in[i] = (const float*)d_in[i];
    a.out = (float*)d_out; a.ws = (unsigned char*)d_ws;
    fill_desc(a, d_in, (unsigned char*)d_ws);
    if (MK_N_LAUNCHES == 1) {
        a.ph_lo = 0; a.ph_hi = NPH; a.coop = 0;
        hipLaunchKernelGGL(fwd_kernel, dim3(grid), dim3(NTHR), LDS_BYTES, stream, a);
    } else {
        for (int p = 0; p < NPH; ++p) { a.ph_lo = p; a.ph_hi = p + 1; a.coop = 0; hipLaunchKernelGGL(fwd_kernel, dim3(grid), dim3(NTHR), LDS_BYTES, stream, a); }
    }
}
```

```cpp
#include <hip/hip_runtime.h>
#include <cstdio>
#include <cstring>
#include <cstdint>

#define LAS __attribute__((address_space(3)))
#define DI __device__ __forceinline__
typedef unsigned short bf16_t;
typedef short bf16x8 __attribute__((ext_vector_type(8)));
typedef short s16x4 __attribute__((ext_vector_type(4)));
typedef float f32x2 __attribute__((ext_vector_type(2)));
typedef float f32x4 __attribute__((ext_vector_type(4)));
typedef float f32x16 __attribute__((ext_vector_type(16)));
typedef unsigned u32x2 __attribute__((ext_vector_type(2)));
typedef unsigned u32x4 __attribute__((ext_vector_type(4)));
typedef __bf16 bf16x2_t __attribute__((ext_vector_type(2)));

DI unsigned pk2(float a, float b) { f32x2 v = {a, b}; bf16x2_t r = __builtin_convertvector(v, bf16x2_t); return __builtin_bit_cast(unsigned, r); }
DI bf16_t f2bf(float a) { return (bf16_t)(pk2(a, 0.f) & 0xffffu); }
DI float bf2f(bf16_t v) { return __uint_as_float(((unsigned)v) << 16); }
DI float bflo(unsigned w) { return __uint_as_float(w << 16); }
DI float bfhi(unsigned w) { return __uint_as_float(w & 0xffff0000u); }
#define dpp_f(v, ctrl) __builtin_bit_cast(float, __builtin_amdgcn_update_dpp(0, __builtin_bit_cast(int, (float)(v)), (ctrl), 0xf, 0xf, true))
#define DPP_QP1032 0xB1
#define DPP_QP2301 0x4E
#define DPP_ROW_HALF_MIRROR 0x141
#define DPP_ROW_MIRROR 0x140
DI float row16_sum(float v) { v += dpp_f(v, DPP_QP1032); v += dpp_f(v, DPP_QP2301); v += dpp_f(v, DPP_ROW_HALF_MIRROR); v += dpp_f(v, DPP_ROW_MIRROR); return v; }
DI float wave_sum(float v) { v = row16_sum(v); v += __shfl_xor(v, 16); v += __shfl_xor(v, 32); return v; }
DI float wave_max(float v) {
#pragma unroll
    for (int o = 1; o < 64; o <<= 1) v = fmaxf(v, __shfl_xor(v, o));
    return v;
}
DI float silu_f(float a) { return a * __builtin_amdgcn_rcpf(1.0f + __expf(-a)); }
DI float sigmoid_f(float a) { return __builtin_amdgcn_rcpf(1.0f + __expf(-a)); }

#define XB_TMO      128
#define XB_XCNT(j)  (256  + 64 * (j))
#define XB_XSUB(j)  (1280 + 64 * (j))
#define XB_XGEN(j)  (2304 + 64 * (j))
#define XB_TOP      3328
#define XB_TOPGEN   3392
#define XCD_BAR_WORDS 3456
#define XB_SPIN_CAP (1u << 22)

__device__ __forceinline__ unsigned xb_ld(unsigned* p)              { return __hip_atomic_load(p, __ATOMIC_RELAXED, __HIP_MEMORY_SCOPE_AGENT); }
__device__ __forceinline__ unsigned xb_add(unsigned* p, unsigned v) { return __hip_atomic_fetch_add(p, v, __ATOMIC_RELAXED, __HIP_MEMORY_SCOPE_AGENT); }
__device__ __forceinline__ unsigned xb_xcc_id() { return (unsigned)__builtin_amdgcn_s_getreg((3 << 11) | 20) & 0xFu; }
#define XB_SPIN(cond, bar) do { unsigned _sp = 0; while (cond) { __builtin_amdgcn_s_sleep(1); \
    if ((++_sp & 255u) == 0u) { if (xb_ld(&(bar)[XB_TMO])) break; if (_sp > XB_SPIN_CAP) { atomicAdd(&(bar)[XB_TMO], 1u); break; } } } } while (0)

struct XcdBarrier { unsigned* bar; unsigned x; volatile LAS unsigned* st; };

__device__ __forceinline__ XcdBarrier xcd_barrier_post(unsigned* bar, volatile LAS unsigned* st) {
    XcdBarrier b; b.bar = bar; b.x = xb_xcc_id(); b.st = st;
    if (threadIdx.x == 0) (void)xb_add(&bar[XB_XCNT(b.x)], 1u);
    return b;
}
__device__ __forceinline__ void xcd_barrier_complete(unsigned* bar, unsigned x, unsigned& nloc, unsigned& nx) {
    const unsigned G = gridDim.x * gridDim.y * gridDim.z;
    unsigned sum, cnt, mine, sp = 0u;
    for (;;) {
        sum = 0u; cnt = 0u; mine = 0u;
#pragma unroll
        for (unsigned j = 0; j < 16; ++j) { const unsigned c = xb_ld(&bar[XB_XCNT(j)]); sum += c; cnt += (c > 0u) ? 1u : 0u; mine = (j == x) ? c : mine; }
        if (sum == G) break;
        __builtin_amdgcn_s_sleep(1);
        if ((++sp & 255u) == 0u) { if (xb_ld(&bar[XB_TMO])) break; if (sp > XB_SPIN_CAP) { atomicAdd(&bar[XB_TMO], 1u); break; } }
    }
    nloc = mine > 0u ? mine : 1u; nx = cnt > 0u ? cnt : 1u;
}
__device__ __forceinline__ void xcd_barrier(const XcdBarrier& b) {
    asm volatile("s_waitcnt vmcnt(0)" ::: "memory");
    __syncthreads();
    if (threadIdx.x == 0) {
        unsigned* bar = b.bar;
        __builtin_amdgcn_s_waitcnt(0);
        unsigned nloc = b.st[0], nx = b.st[1];
        if (nloc == 0u) { xcd_barrier_complete(bar, b.x, nloc, nx); b.st[0] = nloc; b.st[1] = nx; }
        const unsigned old = xb_add(&bar[XB_XSUB(b.x)], 1u);
        const unsigned gen = old / nloc;
        if (old + 1u == (gen + 1u) * nloc) {
            __builtin_amdgcn_fence(__ATOMIC_RELEASE, "agent");
            asm volatile("s_waitcnt vmcnt(0)" ::: "memory");
            const unsigned og = xb_add(&bar[XB_TOP], 1u);
            const unsigned tg = og / nx;
            if (og + 1u == (tg + 1u) * nx) xb_add(&bar[XB_TOPGEN], 1u);
            else XB_SPIN(xb_ld(&bar[XB_TOPGEN]) == tg, bar);
            __builtin_amdgcn_fence(__ATOMIC_ACQUIRE, "agent");
            xb_add(&bar[XB_XGEN(b.x)], 1u);
            asm volatile("s_waitcnt vmcnt(0)" ::: "memory");
        } else {
            XB_SPIN(xb_ld(&bar[XB_XGEN(b.x)]) == gen, bar);
            __builtin_amdgcn_fence(__ATOMIC_ACQUIRE, "agent");
            asm volatile("s_waitcnt vmcnt(0)" ::: "memory");
        }
    }
    __syncthreads();
}

namespace pg8 {
constexpr int BM = 256, BK = 64, HALF = 128, HTB = HALF * BK * 2, STAGE_BYTES = 8 * HTB, NXCD = 8, WGM = 4;
__host__ __device__ __forceinline__ int lds_byte(int r, int c) { const int st = (r >> 4) * 2 + (c >> 5), rr = r & 15, cc = c & 31, ob = rr * 64 + cc * 2; return st * 1024 + (ob ^ (((ob >> 9) & 1) << 5)); }
__host__ __device__ __forceinline__ void stage_rc(int b, int& R, int& C) { const int st = b / 1024, sb = b % 1024, swz = sb ^ (((sb >> 9) & 1) << 5); R = (st >> 1) * 16 + swz / 64; C = (st & 1) * 32 + (swz % 64) / 2; }
__host__ __device__ __forceinline__ int perm32(int rho) { const int n = rho >> 4, i = rho & 15; return 8 * (i >> 2) + 4 * n + (i & 3); }

struct Unit { int pm, pn, pb, pa; };
struct Gemm { const bf16_t* A; const bf16_t* Bt; int M, N, K; };

struct StaticOrder {
    int nM, nN, nwg, G, c;
    __device__ void init(int M, int N, int G_, int c_) { nM = M / BM; nN = N / BM; nwg = nM * nN; G = G_; c = c_; }
    __device__ bool next(int i, Unit& u) const {
        const long L = (long)i * G + c; if (L >= nwg) return false;
        int wgid = (int)L; { const int q = nwg / NXCD, r = nwg % NXCD, xcd = wgid % NXCD, off = wgid / NXCD; wgid = (xcd < r ? xcd * (q + 1) : r * (q + 1) + (xcd - r) * q) + off; }
        const int nig = WGM * nN, gid = wgid / nig, fm = gid * WGM, gsz = (nM - fm) < WGM ? (nM - fm) : WGM;
        u.pm = fm + ((wgid % nig) % gsz); u.pn = (wgid % nig) / gsz; u.pb = u.pn; u.pa = u.pm; return true;
    }
};
struct GroupedOrder {
    int toff[9]; int nN, G, c, a_sparse;
    __device__ void init(const unsigned* cnt, int nN_, int G_, int c_, int a_sparse_) {
        int acc = 0;
#pragma unroll
        for (int e = 0; e < 8; ++e) { toff[e] = acc; acc += ((int)__hip_atomic_load(cnt + 64 * e, __ATOMIC_RELAXED, __HIP_MEMORY_SCOPE_AGENT) + 255) >> 8; }
        toff[8] = acc; nN = nN_; G = G_; c = c_; a_sparse = a_sparse_;
    }
    __device__ bool next(int i, Unit& u) const {
        const long L = (long)i * G + c; const int nwg = toff[8] * nN; if (L >= (long)nwg) return false;
        int wgid = (int)L; { const int q = nwg / NXCD, r = nwg % NXCD, xcd = wgid % NXCD, off = wgid / NXCD; wgid = (xcd < r ? xcd * (q + 1) : r * (q + 1) + (xcd - r) * q) + off; }
        const int nig = WGM * nN, gid = wgid / nig, fm = gid * WGM, gsz = (toff[8] - fm) < WGM ? (toff[8] - fm) : WGM;
        const int rt = fm + ((wgid % nig) % gsz), pn = (wgid % nig) / gsz; int e = 0;
#pragma unroll
        for (int q = 1; q < 8; ++q) e += (rt >= toff[q]) ? 1 : 0;
        int te = 0;
#pragma unroll
        for (int q = 0; q < 8; ++q) te = (q == e) ? toff[q] : te;
        u.pm = rt; u.pn = pn; u.pb = e * nN + pn; u.pa = a_sparse ? (e * 64 + (rt - te)) : rt; return true;
    }
};

template <class Epi, class Sched, bool ALIGN_EPI = true, bool SP2 = true>
__device__ __forceinline__ void gemm_phase(LAS unsigned char* lds, const int tid, const Gemm g, const Sched& S, const Epi& E) {
    const int wid = __builtin_amdgcn_readfirstlane(tid >> 6), lane = tid & 63, wr = wid >> 2, wc = wid & 3, fr = lane & 15, fq = lane >> 4;
    const int K = g.K, nt = K / BK;
    unsigned voffA[2], voffB[2];
#pragma unroll
    for (int i = 0; i < 2; ++i) { int R, C; stage_rc(tid * 16 + i * 8192, R, C); const int Rb = Epi::PERM ? ((R & ~31) + perm32(R & 31)) : R;
        voffA[i] = (unsigned)(R * K + C) * 2u; voffB[i] = (unsigned)(Rb * K + C) * 2u; }
    const size_t kstep = (size_t)(BK * 2);
    const size_t hstep = (size_t)HALF * K * 2;
    const size_t tstep = 2 * hstep;
    const unsigned ldsw = (unsigned)wid * 1024u;
    const int aoff = lds_byte(wr * 64 + fr, fq * 8), boff = lds_byte(wc * 32 + fr, fq * 8);
#define PG8_SA(b, h) (((b) * 2 + (h)) * HTB)
#define PG8_SB(b, h) ((4 + (b) * 2 + (h)) * HTB)
#define PG8_STAGE(bufoff, gbase, voff) do { _Pragma("unroll") for (int _i = 0; _i < 2; ++_i) \
        __builtin_amdgcn_global_load_lds((const unsigned*)((const char*)(gbase) + (voff)[_i]), (LAS unsigned*)(lds + (bufoff) + ldsw + _i * 8192), 16, 0, 0); } while (0)
#define PG8_LDA(dst, b, h) do { _Pragma("unroll") for (int m = 0; m < 4; ++m) _Pragma("unroll") for (int k = 0; k < 2; ++k) dst[m][k] = *(const LAS bf16x8*)(lds + PG8_SA(b, h) + aoff + m * 2048 + k * 1024); } while (0)
#define PG8_LDB(dst, b, h) do { _Pragma("unroll") for (int n = 0; n < 2; ++n) _Pragma("unroll") for (int k = 0; k < 2; ++k) dst[n][k] = *(const LAS bf16x8*)(lds + PG8_SB(b, h) + boff + n * 2048 + k * 1024); } while (0)
#define PG8_MMA(ai, bj, At, Bt) do { __builtin_amdgcn_s_setprio(1); _Pragma("unroll") for (int m = 0; m < 4; ++m) _Pragma("unroll") for (int n = 0; n < 2; ++n) _Pragma("unroll") for (int k = 0; k < 2; ++k) \
        acc[ai][bj][m][n] = __builtin_amdgcn_mfma_f32_16x16x32_bf16(Bt[n][k], At[m][k], acc[ai][bj][m][n], 0, 0, 0); __builtin_amdgcn_s_setprio(0); } while (0)
#define PG8_WAIT_V(n) asm volatile("s_waitcnt vmcnt(" #n ")" ::: "memory")
#define PG8_WAIT_L(n) asm volatile("s_waitcnt lgkmcnt(" #n ")" ::: "memory")
#define PG8_BAR __builtin_amdgcn_s_barrier()
#define PG8_SCHED __builtin_amdgcn_sched_barrier(0)
    Unit cur, nxt; int ui = 0;
    if (!S.next(0, cur)) return;
    f32x4 acc[2][2][4][2];
#pragma unroll
    for (int a = 0; a < 2; ++a)
#pragma unroll
        for (int b = 0; b < 2; ++b)
#pragma unroll
            for (int m = 0; m < 4; ++m)
#pragma unroll
                for (int n = 0; n < 2; ++n) acc[a][b][m][n] = (f32x4){0.f, 0.f, 0.f, 0.f};
    bf16x8 At[4][2], B0[2][2], B1[2][2];
    const char* cA = (const char*)g.A + (size_t)cur.pa * tstep; const char* cB = (const char*)g.Bt + (size_t)cur.pb * tstep;
    if constexpr (SP2) {
        PG8_STAGE(PG8_SB(0, 0), cB, voffB); PG8_STAGE(PG8_SB(0, 1), cB + hstep, voffB); PG8_STAGE(PG8_SA(0, 0), cA, voffA); PG8_STAGE(PG8_SA(0, 1), cA + hstep, voffA);
        if (wr == 1) PG8_BAR;
        PG8_WAIT_V(2); PG8_BAR;
        PG8_STAGE(PG8_SB(1, 0), cB + kstep, voffB); PG8_STAGE(PG8_SA(1, 0), cA + kstep, voffA); PG8_STAGE(PG8_SB(1, 1), cB + hstep + kstep, voffB);
        PG8_WAIT_V(6); PG8_BAR;
    } else {
        PG8_STAGE(PG8_SB(0, 0), cB, voffB); PG8_STAGE(PG8_SA(0, 0), cA, voffA); PG8_STAGE(PG8_SB(0, 1), cB + hstep, voffB); PG8_STAGE(PG8_SA(0, 1), cA + hstep, voffA);
        if (wr == 1) PG8_BAR;
        PG8_WAIT_V(4); PG8_BAR;
        PG8_STAGE(PG8_SB(1, 0), cB + kstep, voffB); PG8_STAGE(PG8_SA(1, 0), cA + kstep, voffA); PG8_STAGE(PG8_SB(1, 1), cB + hstep + kstep, voffB);
        PG8_WAIT_V(6); PG8_BAR;
    }
    for (;;) {
        const bool has_next = S.next(ui + 1, nxt);
        const char* nA = has_next ? (const char*)g.A + (size_t)nxt.pa * tstep : cA; const char* nB = has_next ? (const char*)g.Bt + (size_t)nxt.pb * tstep : cB;
        for (int t = 0; t < nt; t += 2) {
            const bool last = (t == nt - 2);
            const char* a1 = cA + (size_t)(t + 1) * kstep;
            const char* a2 = last ? nA : cA + (size_t)(t + 2) * kstep; const char* b2 = last ? nB : cB + (size_t)(t + 2) * kstep;
            const char* a3 = a2 + kstep; const char* b3 = b2 + kstep;
            if constexpr (SP2) {
            PG8_LDB(B0, 0, 0); PG8_LDB(B1, 0, 1); PG8_SCHED; PG8_LDA(At, 0, 0); PG8_STAGE(PG8_SA(1, 1), a1 + hstep, voffA);
            PG8_WAIT_V(8); PG8_WAIT_L(0); PG8_BAR; PG8_MMA(0, 0, At, B0); PG8_MMA(0, 1, At, B1); PG8_BAR; PG8_SCHED;
            PG8_LDA(At, 0, 1); PG8_STAGE(PG8_SB(0, 0), b2, voffB); PG8_STAGE(PG8_SB(0, 1), b2 + hstep, voffB); PG8_STAGE(PG8_SA(0, 0), a2, voffA);
            PG8_WAIT_V(8); PG8_WAIT_L(0); PG8_BAR; PG8_MMA(1, 0, At, B0); PG8_MMA(1, 1, At, B1); PG8_BAR; PG8_SCHED;
            PG8_LDB(B0, 1, 0); PG8_LDB(B1, 1, 1); PG8_SCHED; PG8_LDA(At, 1, 0); PG8_STAGE(PG8_SA(0, 1), a2 + hstep, voffA);
            PG8_WAIT_V(8); PG8_WAIT_L(0); PG8_BAR; PG8_MMA(0, 0, At, B0); PG8_MMA(0, 1, At, B1); PG8_BAR; PG8_SCHED;
            PG8_LDA(At, 1, 1); PG8_STAGE(PG8_SB(1, 0), b3, voffB); PG8_STAGE(PG8_SB(1, 1), b3 + hstep, voffB); PG8_STAGE(PG8_SA(1, 0), a3, voffA);
            PG8_WAIT_V(8); PG8_WAIT_L(0); PG8_BAR; PG8_MMA(1, 0, At, B0); PG8_MMA(1, 1, At, B1); PG8_BAR; PG8_SCHED;
            } else {
            PG8_LDB(B0, 0, 0); PG8_SCHED; PG8_LDA(At, 0, 0); PG8_STAGE(PG8_SA(1, 1), a1 + hstep, voffA);
            PG8_WAIT_L(8); PG8_BAR; PG8_WAIT_L(0); PG8_MMA(0, 0, At, B0); PG8_BAR; PG8_SCHED;
            PG8_LDB(B1, 0, 1); PG8_STAGE(PG8_SB(0, 0), b2, voffB);
            PG8_BAR; PG8_WAIT_L(0); PG8_MMA(0, 1, At, B1); PG8_BAR;
            PG8_LDA(At, 0, 1); PG8_STAGE(PG8_SA(0, 0), a2, voffA);
            PG8_BAR; PG8_WAIT_L(0); PG8_MMA(1, 0, At, B0); PG8_BAR; PG8_SCHED;
            PG8_STAGE(PG8_SB(0, 1), b2 + hstep, voffB);
            PG8_WAIT_V(6); PG8_BAR; PG8_MMA(1, 1, At, B1); PG8_BAR;
            PG8_LDB(B0, 1, 0); PG8_SCHED; PG8_LDA(At, 1, 0); PG8_STAGE(PG8_SA(0, 1), a2 + hstep, voffA);
            PG8_WAIT_L(8); PG8_BAR; PG8_WAIT_L(0); PG8_MMA(0, 0, At, B0); PG8_BAR; PG8_SCHED;
            PG8_LDB(B1, 1, 1); PG8_STAGE(PG8_SB(1, 0), b3, voffB);
            PG8_BAR; PG8_WAIT_L(0); PG8_MMA(0, 1, At, B1); PG8_BAR;
            PG8_LDA(At, 1, 1); PG8_STAGE(PG8_SA(1, 0), a3, voffA);
            PG8_BAR; PG8_WAIT_L(0); PG8_MMA(1, 0, At, B0); PG8_BAR; PG8_SCHED;
            PG8_STAGE(PG8_SB(1, 1), b3 + hstep, voffB);
            PG8_WAIT_V(6); PG8_BAR; PG8_MMA(1, 1, At, B1); PG8_BAR;
            }
        }
        if constexpr (ALIGN_EPI) { if (wr == 0) PG8_BAR; }
        E(acc, cur, wr, wc, fr, fq);
        if (!has_next) break;
#pragma unroll
        for (int a = 0; a < 2; ++a)
#pragma unroll
            for (int b = 0; b < 2; ++b)
#pragma unroll
                for (int m = 0; m < 4; ++m)
#pragma unroll
                    for (int n = 0; n < 2; ++n) acc[a][b][m][n] = (f32x4){0.f, 0.f, 0.f, 0.f};
        cur = nxt; cA = nA; cB = nB; ++ui;
        if constexpr (ALIGN_EPI) { if (wr == 1) PG8_BAR; }
    }
    PG8_WAIT_V(0);
    if constexpr (!ALIGN_EPI) { if (wr == 0) PG8_BAR; }
    PG8_BAR;
#undef PG8_SA
#undef PG8_SB
#undef PG8_STAGE
#undef PG8_LDA
#undef PG8_LDB
#undef PG8_MMA
#undef PG8_WAIT_V
#undef PG8_WAIT_L
#undef PG8_BAR
#undef PG8_SCHED
}

typedef const f32x4 (&AccT)[2][2][4][2];

struct EpiBf16Plain {
    static constexpr bool PERM = true;
    bf16_t* O; int ldc;
    __device__ __forceinline__ void operator()(AccT acc, const Unit& u, int wr, int wc, int fr, int fq) const {
        const int row0 = u.pm * BM + wr * 64 + fr, col0 = u.pn * BM + wc * 32 + 8 * fq;
#pragma unroll
        for (int ai = 0; ai < 2; ++ai)
#pragma unroll
            for (int m = 0; m < 4; ++m) { bf16_t* rowp = O + (size_t)(row0 + ai * HALF + m * 16) * ldc + col0;
#pragma unroll
                for (int bj = 0; bj < 2; ++bj) { const f32x4 v0 = acc[ai][bj][m][0], v1 = acc[ai][bj][m][1];
                    u32x4 w; w.x = pk2(v0[0], v0[1]); w.y = pk2(v0[2], v0[3]); w.z = pk2(v1[0], v1[1]); w.w = pk2(v1[2], v1[3]);
                    *(u32x4*)(rowp + bj * HALF) = w; } }
    }
};
struct EpiProj {
    static constexpr bool PERM = true;
    bf16_t* O; float* AB;
    __device__ __forceinline__ void operator()(AccT acc, const Unit& u, int wr, int wc, int fr, int fq) const {
        const int row0 = u.pm * BM + wr * 64 + fr, col0 = u.pn * BM + wc * 32 + 8 * fq;
        const bool ab = (u.pn == 8) && (wc == 0) && (fq == 0);
#pragma unroll
        for (int ai = 0; ai < 2; ++ai)
#pragma unroll
            for (int m = 0; m < 4; ++m) { const int row = row0 + ai * HALF + m * 16; bf16_t* rowp = O + (size_t)row * 2816 + col0;
#pragma unroll
                for (int bj = 0; bj < 2; ++bj) { const f32x4 v0 = acc[ai][bj][m][0], v1 = acc[ai][bj][m][1];
                    u32x4 w; w.x = pk2(v0[0], v0[1]); w.y = pk2(v0[2], v0[3]); w.z = pk2(v1[0], v1[1]); w.w = pk2(v1[2], v1[3]);
                    *(u32x4*)(rowp + bj * HALF) = w; }
                if (ab) { float* p = AB + (size_t)row * 8; *(f32x4*)p = acc[ai][0][m][0]; *(f32x4*)(p + 4) = acc[ai][0][m][1]; } }
    }
};
struct EpiSwiGLU {
    static constexpr bool PERM = true;
    bf16_t* O; int ldc;
    __device__ __forceinline__ void operator()(AccT acc, const Unit& u, int wr, int wc, int fr, int fq) const {
        const int row0 = u.pm * BM + wr * 64 + fr, col0 = u.pn * HALF + wc * 32 + 8 * fq;
#pragma unroll
        for (int ai = 0; ai < 2; ++ai)
#pragma unroll
            for (int m = 0; m < 4; ++m) { bf16_t* rowp = O + (size_t)(row0 + ai * HALF + m * 16) * ldc + col0;
                float r[8];
#pragma unroll
                for (int n = 0; n < 2; ++n)
#pragma unroll
                    for (int j = 0; j < 4; ++j) r[n * 4 + j] = silu_f(acc[ai][0][m][n][j]) * acc[ai][1][m][n][j];
                u32x4 w; w.x = pk2(r[0], r[1]); w.y = pk2(r[2], r[3]); w.z = pk2(r[4], r[5]); w.w = pk2(r[6], r[7]);
                *(u32x4*)rowp = w; }
    }
};
struct EpiGLU {
    static constexpr bool PERM = true;
    bf16_t* O; const float* bias;
    __device__ __forceinline__ void operator()(AccT acc, const Unit& u, int wr, int wc, int fr, int fq) const {
        const int row0 = u.pm * BM + wr * 64 + fr, col0 = u.pn * HALF + wc * 32 + 8 * fq;
        const f32x4 ba0 = *(const f32x4*)(bias + col0), ba1 = *(const f32x4*)(bias + col0 + 4), bb0 = *(const f32x4*)(bias + 512 + col0), bb1 = *(const f32x4*)(bias + 512 + col0 + 4);
#pragma unroll
        for (int ai = 0; ai < 2; ++ai)
#pragma unroll
            for (int m = 0; m < 4; ++m) { bf16_t* rowp = O + (size_t)(row0 + ai * HALF + m * 16) * 1024 + 512 + col0;
                const f32x4 a0 = acc[ai][0][m][0] + ba0, a1 = acc[ai][0][m][1] + ba1, b0 = acc[ai][1][m][0] + bb0, b1 = acc[ai][1][m][1] + bb1;
                u32x4 w; w.x = pk2(a0[0] * sigmoid_f(b0[0]), a0[1] * sigmoid_f(b0[1])); w.y = pk2(a0[2] * sigmoid_f(b0[2]), a0[3] * sigmoid_f(b0[3]));
                w.z = pk2(a1[0] * sigmoid_f(b1[0]), a1[1] * sigmoid_f(b1[1])); w.w = pk2(a1[2] * sigmoid_f(b1[2]), a1[3] * sigmoid_f(b1[3]));
                *(u32x4*)rowp = w; }
    }
};
template <bool XF32> struct EpiResidT {
    static constexpr bool PERM = true;
    const void* X; bf16_t* Y; const float* gate;
    __device__ __forceinline__ void operator()(AccT acc, const Unit& u, int wr, int wc, int fr, int fq) const {
        const int row0 = u.pm * BM + wr * 64 + fr, col0 = u.pn * BM + wc * 32 + 8 * fq;
        const float* gp = gate + (size_t)((u.pm * BM) >> 12) * 6144 + col0;
        f32x4 gv[2][2];
#pragma unroll
        for (int bj = 0; bj < 2; ++bj)
#pragma unroll
            for (int n = 0; n < 2; ++n) gv[bj][n] = *(const f32x4*)(gp + bj * HALF + 4 * n);
#pragma unroll
        for (int ai = 0; ai < 2; ++ai) {
            f32x4 xv[4][2][2];
            if (XF32) {
#pragma unroll
                for (int m = 0; m < 4; ++m)
#pragma unroll
                    for (int bj = 0; bj < 2; ++bj)
#pragma unroll
                        for (int n = 0; n < 2; ++n) xv[m][bj][n] = *(const f32x4*)((const float*)X + (size_t)(row0 + ai * HALF + m * 16) * 1024 + col0 + bj * HALF + 4 * n);
            } else {
                u32x4 xw[4][2];
#pragma unroll
                for (int m = 0; m < 4; ++m)
#pragma unroll
                    for (int bj = 0; bj < 2; ++bj) xw[m][bj] = *(const u32x4*)((const bf16_t*)X + (size_t)(row0 + ai * HALF + m * 16) * 1024 + col0 + bj * HALF);
#pragma unroll
                for (int m = 0; m < 4; ++m)
#pragma unroll
                    for (int bj = 0; bj < 2; ++bj) { const u32x4 w = xw[m][bj];
                        xv[m][bj][0] = (f32x4){bflo(w.x), bfhi(w.x), bflo(w.y), bfhi(w.y)}; xv[m][bj][1] = (f32x4){bflo(w.z), bfhi(w.z), bflo(w.w), bfhi(w.w)}; }
            }
            __builtin_amdgcn_sched_barrier(0);
#pragma unroll
            for (int m = 0; m < 4; ++m)
#pragma unroll
                for (int bj = 0; bj < 2; ++bj) { const f32x4 a = xv[m][bj][0] + gv[bj][0] * acc[ai][bj][m][0], c = xv[m][bj][1] + gv[bj][1] * acc[ai][bj][m][1];
                    u32x4 o; o.x = pk2(a[0], a[1]); o.y = pk2(a[2], a[3]); o.z = pk2(c[0], c[1]); o.w = pk2(c[2], c[3]);
                    *(u32x4*)(Y + (size_t)(row0 + ai * HALF + m * 16) * 1024 + col0 + bj * HALF) = o; }
            __builtin_amdgcn_sched_barrier(0);
        }
    }
};
struct EpiQKNorm {
    static constexpr bool PERM = true;
    bf16_t* Q; bf16_t* K; const float* qw; const float* kw;
    __device__ __forceinline__ void operator()(AccT acc, const Unit& u, int wr, int wc, int fr, int fq) const {
        const bool isK = u.pn >= 4;
        bf16_t* dst = isK ? K : Q; const float* wv = isK ? kw : qw; const float sc = isK ? 1.0f : 0.125f * 1.4426950408889634f;
        const int row0 = u.pm * BM + wr * 64 + fr, tc0 = (u.pn & 3) * BM + wc * 64;
        const float* wp = wv + 8 * fq;
        f32x4 wq[2][2];
#pragma unroll
        for (int bj = 0; bj < 2; ++bj) { wq[bj][0] = *(const f32x4*)(wp + 32 * bj); wq[bj][1] = *(const f32x4*)(wp + 32 * bj + 4); }
#pragma unroll
        for (int ai = 0; ai < 2; ++ai)
#pragma unroll
            for (int m = 0; m < 4; ++m) {
                float ss = 0.f;
#pragma unroll
                for (int bj = 0; bj < 2; ++bj)
#pragma unroll
                    for (int n = 0; n < 2; ++n) { const f32x4 x = acc[ai][bj][m][n]; ss += (x[0] * x[0] + x[1] * x[1]) + (x[2] * x[2] + x[3] * x[3]); }
                ss += __shfl_xor(ss, 16); ss += __shfl_xor(ss, 32);
                const float rs = __builtin_amdgcn_rsqf(ss * (1.0f / 64.0f) + 1e-6f) * sc;
                bf16_t* rowp = dst + (size_t)(row0 + ai * HALF + m * 16) * 1024 + tc0 + 8 * fq;
#pragma unroll
                for (int bj = 0; bj < 2; ++bj) { const f32x4 v0 = acc[ai][bj][m][0] * rs * wq[bj][0], v1 = acc[ai][bj][m][1] * rs * wq[bj][1];
                    u32x4 w; w.x = pk2(v0[0], v0[1]); w.y = pk2(v0[2], v0[3]); w.z = pk2(v1[0], v1[1]); w.w = pk2(v1[2], v1[3]);
                    *(u32x4*)(rowp + 32 * bj) = w; } }
    }
};
}
constexpr int D = 1024, NB = 4, SEQ = 4096, M = NB * SEQ, FF = 2816, NEXP = 8;
constexpr int EVEN_IN = 2568, EVEN_INP = 2816;
constexpr int MS = 2 * M + NEXP * 256;
constexpr int NWAVES = 8, NTHR = 512;
constexpr int LDS_BYTES = 147456;
constexpr int NPH = 36;

enum { I_X = 0, I_C, I_ADAW, I_ADAB, I_NMIX, I_NFFN, I_EWIN, I_ECONV, I_EALOG, I_EDTB, I_EGNW, I_ELRE, I_ELIM, I_ELSTEP, I_EBRE, I_EBIM, I_ECRE, I_ECIM,
       I_EDSKIP, I_EGLUW, I_EGLUB, I_EWOUT, I_EW13, I_EW2, I_OWQKV, I_OQNW, I_OKNW, I_OLQ1, I_OLK1, I_OLQ2, I_OLK2, I_OSUBLN, I_OWOUT, I_OROUTER, I_OEW13, I_OEW2, N_IN };

constexpr size_t al256(size_t x) { return (x + 255) & ~(size_t)255; }
constexpr size_t WS_CTL = 0;
constexpr size_t CTL_BYTES = 32768;
constexpr size_t CW_PQ = 14336;
constexpr size_t CW_CNT = 16384;
constexpr size_t WS_MOD = WS_CTL + CTL_BYTES;
constexpr size_t WS_COEF = WS_MOD + al256((size_t)4 * 4 * 6144 * 4);
constexpr size_t COEF_AR = 0, COEF_AI = 8192, COEF_A64R = 16384, COEF_A64I = 24576, COEF_BBR = 32768, COEF_BBI = 32768 + 131072, COEF_BYTES = 32768 + 2 * 131072;
constexpr size_t WS_META = WS_COEF + 2 * COEF_BYTES;
constexpr size_t WS_ROUTE = WS_META + 4096;
constexpr size_t WS_WIN = WS_ROUTE + (size_t)2 * M * 16;
constexpr size_t SZ_WIN = (size_t)EVEN_INP * D * 2;
constexpr size_t WS_GLU = WS_WIN + 2 * SZ_WIN;
constexpr size_t SZ_GLU = (size_t)1024 * 512 * 2;
constexpr size_t WS_WOE = WS_GLU + 2 * SZ_GLU;
constexpr size_t SZ_SQ = (size_t)D * D * 2;
constexpr size_t WS_W13 = WS_WOE + 2 * SZ_SQ;
constexpr size_t SZ_W13 = (size_t)2 * FF * D * 2;
constexpr size_t WS_W2 = WS_W13 + 2 * SZ_W13;
constexpr size_t SZ_W2 = (size_t)D * FF * 2;
constexpr size_t WS_WQK = WS_W2 + 2 * SZ_W2;
constexpr size_t SZ_WQK = (size_t)2048 * D * 2;
constexpr size_t WS_WV = WS_WQK + 2 * SZ_WQK;
constexpr size_t WS_WOO = WS_WV + 2 * SZ_SQ;
constexpr size_t WS_EW13 = WS_WOO + 2 * SZ_SQ;
constexpr size_t SZ_EW13 = (size_t)NEXP * SZ_W13;
constexpr size_t WS_EW2 = WS_EW13 + 2 * SZ_EW13;
constexpr size_t SZ_EW2 = (size_t)NEXP * SZ_W2;
constexpr size_t WS_H = WS_EW2 + 2 * SZ_EW2;
constexpr size_t WS_PROJ = WS_H + (size_t)M * D * 2;
constexpr size_t WS_QN = WS_PROJ, WS_KN = WS_QN + (size_t)M * D * 2, WS_VT = WS_KN + (size_t)M * D * 2;
constexpr size_t WS_AB = WS_PROJ + (size_t)M * EVEN_INP * 2;
constexpr size_t WS_GU = WS_AB + (size_t)M * 8 * 4;
constexpr size_t SZ_G128 = (size_t)1024 * 64 * 128 * 2;
constexpr size_t WS_GWN = WS_GU + SZ_G128, WS_GQG = WS_GWN + SZ_G128, WS_GKGT = WS_GQG + SZ_G128;
constexpr size_t WS_GQK = WS_GKGT + SZ_G128;
constexpr size_t WS_GL = WS_GQK + (size_t)1024 * 64 * 64 * 2;
constexpr size_t WS_OG = WS_GL + 4096;
constexpr size_t WS_S5E = WS_OG + (size_t)M * 512 * 4;
constexpr size_t WS_GY = WS_S5E + (size_t)4 * 64 * 32 * 64 * 8;
constexpr size_t WS_CAT = WS_GY + (size_t)M * 512 * 2;
constexpr size_t WS_ACT = WS_CAT + (size_t)M * D * 2;
constexpr size_t WS_ACTS = WS_ACT + (size_t)M * FF * 2;
constexpr size_t WS_FS = WS_ACTS + (size_t)MS * FF * 2;
constexpr size_t WS_GA = WS_FS + (size_t)MS * D * 2;
constexpr size_t WS_GBT = WS_GA + (size_t)1024 * 16384 * 2;
constexpr size_t WS_GST = WS_GBT + (size_t)1024 * 16384 * 2;
constexpr size_t WS_HS = WS_GST + (size_t)1024 * 16384 * 2;
constexpr size_t WS_DUMMY = WS_HS + (size_t)NEXP * M * D * 2;
constexpr size_t WS_XB = WS_DUMMY;
constexpr size_t WS_END = WS_DUMMY + (size_t)M * D * 4;

struct Route { int p0, p1; float g0, g1; };
struct TDesc { const float* src; bf16_t* dst; int ld, K, N, nblk, E, map, mp, item0; size_t src_es; int dst_erows; int pad_; };
constexpr int NDESC = 20;
struct Args {
    const float* in[N_IN];
    float* out; unsigned char* ws;
    TDesc td[NDESC];
    int n_items; int ph_lo, ph_hi, coop;
    int n_pro, cv_lo[2], cv_hi[2];
};

struct Ctx {
    LAS unsigned char* lds; int tid, lane, wave, G, bid, zero;
    const float* const* in; float* out; unsigned char* ws;
};

DI int td_maprow(int map, int mp, int n0) {
    if (map == 0) return n0;
    if (map == 1) { if (n0 < mp) return 256 * (n0 >> 7) + (n0 & 127); const int n1 = n0 - mp; return 256 * (n1 >> 7) + 128 + (n1 & 127); }
    const int pn = n0 >> 8, r = n0 & 255, wc = r >> 6, bj = (r & 63) >> 5; return 256 * pn + 128 * bj + 32 * wc;
}
DI void p0_transpose_item(const TDesc& t, int item, int lane) {
    const int per_e = (t.K >> 6) * t.nblk; const int e = item / per_e, r = item - e * per_e, kb = r / t.nblk, nb = r - kb * t.nblk, k0 = 64 * kb, n0 = 32 * nb;
    const int g = lane >> 3, c4 = lane & 7, col = n0 + 4 * c4; const bool ok = col < t.N;
    const float* W = t.src + (size_t)e * t.src_es + (size_t)(k0 + 8 * g) * t.ld + col;
    f32x4 v[8];
#pragma unroll
    for (int i = 0; i < 8; ++i) v[i] = ok ? *(const f32x4*)(W + (size_t)i * t.ld) : (f32x4){0.f, 0.f, 0.f, 0.f};
    const int drow0 = td_maprow(t.map, t.mp, n0) + e * t.dst_erows + 4 * c4;
    bf16_t* dp = t.dst + (size_t)drow0 * t.K + k0 + 8 * g;
#pragma unroll
    for (int q = 0; q < 4; ++q) { u32x4 o; o.x = pk2(v[0][q], v[1][q]); o.y = pk2(v[2][q], v[3][q]); o.z = pk2(v[4][q], v[5][q]); o.w = pk2(v[6][q], v[7][q]);
        *(u32x4*)(dp + (size_t)q * t.K) = o; }
}
#define CAS __attribute__((address_space(4)))
DI const CAS Args* kargs() { return (const CAS Args*)__builtin_amdgcn_kernarg_segment_ptr(); }
struct ConvSt { f32x4 v[8]; unsigned doff;
    bf16_t* db; int K, hi;
    int next, end, di, pend; };
DI void cv_init(ConvSt& S, int lo, int hi, int gw) { S.next = lo + gw; S.end = hi; S.di = 0; S.pend = 0; S.doff = 0u; S.db = nullptr; S.K = 64; S.hi = 0;
#pragma unroll
    for (int i = 0; i < 8; ++i) S.v[i] = (f32x4){0.f, 0.f, 0.f, 0.f}; }
DI void cv_issue(ConvSt& S, int lane, int stride) {
    const int it = S.next; S.next += stride; const CAS Args* A = kargs();
    if (it >= S.hi) {
        int di = S.di;
        while (di + 1 < NDESC && it >= A->td[di + 1].item0) ++di;
        S.di = di; S.db = A->td[di].dst; S.K = A->td[di].K; S.hi = (di + 1 < NDESC) ? A->td[di + 1].item0 : 0x7fffffff;
    }
    const CAS TDesc* t = &A->td[S.di];
    const int K = S.K, nblk = t->nblk, ld = t->ld, item = it - t->item0;
    const int per_e = (K >> 6) * nblk; const int e = item / per_e, r = item - e * per_e, kb = r / nblk, nb = r - kb * nblk, k0 = 64 * kb, n0 = 32 * nb;
    const int g = lane >> 3, c4 = lane & 7, col = n0 + 4 * c4; const bool ok = col < t->N;
    const float* W = t->src + (size_t)e * t->src_es + (size_t)(k0 + 8 * g) * ld + col;
#pragma unroll
    for (int i = 0; i < 8; ++i) S.v[i] = ok ? *(const f32x4*)(W + (size_t)i * ld) : (f32x4){0.f, 0.f, 0.f, 0.f};
    const int drow0 = td_maprow(t->map, t->mp, n0) + e * t->dst_erows + 4 * c4;
    S.doff = (unsigned)(((size_t)drow0 * K + k0 + 8 * g) * 2); S.pend = 1;
}
DI void cv_finish(ConvSt& S) {
    unsigned char* dp = (unsigned char*)S.db + S.doff;
#pragma unroll
    for (int q = 0; q < 4; ++q) { u32x4 o; o.x = pk2(S.v[0][q], S.v[1][q]); o.y = pk2(S.v[2][q], S.v[3][q]); o.z = pk2(S.v[4][q], S.v[5][q]); o.w = pk2(S.v[6][q], S.v[7][q]);
        *(u32x4*)(dp + (size_t)q * S.K * 2) = o; }
    S.pend = 0;
}
#define CV_STEP(S, LANE, STRIDE) do { if ((S).pend) cv_finish(S); if ((S).next < (S).end) cv_issue(S, LANE, STRIDE); } while (0)
#define CV_DRAIN(S, LANE, STRIDE) do { while ((S).pend || (S).next < (S).end) { if ((S).pend) cv_finish(S); if ((S).next < (S).end) cv_issue(S, LANE, STRIDE); } } while (0)
DI void p0_prologue(const Ctx& C, const Args& A) {
    {
        LAS float* red = (LAS float*)(C.lds + 16384);
        LAS float* cond = (LAS float*)(C.lds);
        const float* cc = C.in[C.zero + I_C];
        for (int k = C.tid; k < 4 * D; k += NTHR) { const float x = cc[k]; cond[k] = x / (1.0f + expf(-x)); }
        __syncthreads();
        for (int it = C.bid; it < 4 * 24; it += C.G) {
            const int l = it / 24, jb = it - l * 24, j = 256 * jb + 4 * C.lane;
            const float* W = C.in[C.zero + I_ADAW] + (size_t)l * D * 6144 + (size_t)(128 * C.wave) * 6144 + j;
            f32x4 a0 = {0.f, 0.f, 0.f, 0.f}, a1 = a0, a2 = a0, a3 = a0;
#pragma unroll 8
            for (int k = 0; k < 128; ++k) { const f32x4 w = *(const f32x4*)(W + (size_t)k * 6144); const int kk = 128 * C.wave + k;
                a0 += w * cond[kk]; a1 += w * cond[D + kk]; a2 += w * cond[2 * D + kk]; a3 += w * cond[3 * D + kk]; }
            *(LAS f32x4*)(red + (C.wave * 4 + 0) * 256 + 4 * C.lane) = a0; *(LAS f32x4*)(red + (C.wave * 4 + 1) * 256 + 4 * C.lane) = a1;
            *(LAS f32x4*)(red + (C.wave * 4 + 2) * 256 + 4 * C.lane) = a2; *(LAS f32x4*)(red + (C.wave * 4 + 3) * 256 + 4 * C.lane) = a3;
            __syncthreads();
            if (C.wave < 4) { f32x4 s = *(const f32x4*)(C.in[C.zero + I_ADAB] + (size_t)l * 6144 + j);
#pragma unroll
                for (int w = 0; w < 8; ++w) s += *(const LAS f32x4*)(red + (w * 4 + C.wave) * 256 + 4 * C.lane);
                *(f32x4*)((float*)(C.ws + WS_MOD) + ((size_t)l * 4 + C.wave) * 6144 + j) = s; }
            __syncthreads();
        }
        __syncthreads();
    }
    for (int id = C.bid * NTHR + C.tid; id < 2 * 2048; id += C.G * NTHR) {
        const int i = id >> 11, gn = id & 2047, g = gn >> 6;
        double lr = (double)C.in[C.zero + I_ELRE][i * 2048 + gn]; if (lr > -1e-4) lr = -1e-4;
        const double li = (double)C.in[C.zero + I_ELIM][i * 2048 + gn], dt = exp((double)C.in[C.zero + I_ELSTEP][i * 32 + g]);
        const double mag = exp(lr * dt), ar = mag * cos(li * dt), ai = mag * sin(li * dt), nr = ar - 1.0, ni = ai, den = lr * lr + li * li;
        const double cr = (nr * lr + ni * li) / den, ci = (ni * lr - nr * li) / den;
        const double m64 = exp(256.0 * lr * dt), a64r = m64 * cos(256.0 * li * dt), a64i = m64 * sin(256.0 * li * dt);
        unsigned char* cf = C.ws + WS_COEF + (size_t)i * COEF_BYTES;
        ((float*)(cf + COEF_AR))[gn] = (float)ar; ((float*)(cf + COEF_AI))[gn] = (float)ai; ((float*)(cf + COEF_A64R))[gn] = (float)a64r; ((float*)(cf + COEF_A64I))[gn] = (float)a64i;
        const float* bre = C.in[C.zero + I_EBRE] + ((size_t)i * 2048 + gn) * 16; const float* bim = C.in[C.zero + I_EBIM] + ((size_t)i * 2048 + gn) * 16;
#pragma unroll
        for (int c = 0; c < 16; ++c) { const double br = bre[c], bi = bim[c];
            ((float*)(cf + COEF_BBR))[gn * 16 + c] = (float)(cr * br - ci * bi); ((float*)(cf + COEF_BBI))[gn * 16 + c] = (float)(cr * bi + ci * br); }
    }
    {
        unsigned* qhead = (unsigned*)(C.ws + WS_CTL + CW_PQ);
        int di = 0;
        for (;;) {
            unsigned it0 = 0u;
            if (C.lane == 0) it0 = __hip_atomic_fetch_add(qhead, 8u, __ATOMIC_RELAXED, __HIP_MEMORY_SCOPE_AGENT);
            it0 = (unsigned)__builtin_amdgcn_readfirstlane((int)it0);
            if (it0 >= (unsigned)A.n_pro) break;
#pragma unroll 1
            for (int q = 0; q < 8; ++q) { const int it = (int)it0 + q; if (it >= A.n_pro) break;
                while (di + 1 < NDESC && it >= A.td[di + 1].item0) ++di;
                p0_transpose_item(A.td[di], it - A.td[di].item0, C.lane); }
        }
    }
}

DI int opv2_(int x) { asm volatile("" : "+v"(x)); return x; }
DI u32x4 pack8f(const f32x4 a, const f32x4 b) { u32x4 o; o.x = pk2(a[0], a[1]); o.y = pk2(a[2], a[3]); o.z = pk2(b[0], b[1]); o.w = pk2(b[2], b[3]); return o; }
template <bool COMBINE, bool NORM, bool ROUTER, bool XF32, bool OUTF32 = false, int RB = (COMBINE || ROUTER) ? 2 : 4>
DI void norm_phase(const Ctx& C, const void* xsrc, void* xdst, const float* nw, const float* modl, int sc_off, int sh_off, bf16_t* H,
                   const Route* rprev, const bf16_t* FS, const float* g2prev, const unsigned* cntprev, const float* rw, unsigned* cnt, Route* rout, bf16_t* HSx) {
    const int gw = C.bid * NWAVES + C.wave, NGW = C.G * NWAVES;
    int coff[8];
    if (COMBINE) { int acc = 0;
#pragma unroll
        for (int e = 0; e < 8; ++e) { coff[e] = acc; acc += ((int)__hip_atomic_load(cntprev + 64 * e, __ATOMIC_RELAXED, __HIP_MEMORY_SCOPE_AGENT) + 255) & ~255; } }
    LAS f32x4* RW0 = (LAS f32x4*)(C.lds); LAS f32x4* RW1 = (LAS f32x4*)(C.lds + 16384);
    if (ROUTER) {
        for (int col = C.tid; col < D; col += NTHR) { const int ix = ((col >> 9) * 8 + (col & 7)) * 64 + ((col & 511) >> 3);
            RW0[ix] = *(const f32x4*)(rw + (size_t)col * 8); RW1[ix] = *(const f32x4*)(rw + (size_t)col * 8 + 4); }
        __syncthreads();
    }
    f32x4 gsc[4], shv[4]; int bcur = -1;
    for (int row0 = gw * RB; row0 < M; row0 += NGW * RB) {
        const int b = row0 >> 12;
        f32x4 v[RB][4];
        if (XF32) {
#pragma unroll
            for (int i = 0; i < RB; ++i)
#pragma unroll
                for (int q = 0; q < 4; ++q) v[i][q] = *(const f32x4*)((const float*)xsrc + (size_t)(row0 + i) * D + 8 * C.lane + 512 * (q >> 1) + 4 * (q & 1));
        } else {
            u32x4 xw[RB][2];
#pragma unroll
            for (int i = 0; i < RB; ++i)
#pragma unroll
                for (int j2 = 0; j2 < 2; ++j2) xw[i][j2] = *(const u32x4*)((const bf16_t*)xsrc + (size_t)(row0 + i) * D + 8 * C.lane + 512 * j2);
#pragma unroll
            for (int i = 0; i < RB; ++i)
#pragma unroll
                for (int j2 = 0; j2 < 2; ++j2) { const u32x4 w = xw[i][j2];
                    v[i][2 * j2] = (f32x4){bflo(w.x), bfhi(w.x), bflo(w.y), bfhi(w.y)}; v[i][2 * j2 + 1] = (f32x4){bflo(w.z), bfhi(w.z), bflo(w.w), bfhi(w.w)}; }
        }
        if (NORM && b != bcur) { bcur = b;
#pragma unroll
            for (int q = 0; q < 4; ++q) { const int c = 8 * C.lane + 512 * (q >> 1) + 4 * (q & 1);
                gsc[q] = *(const f32x4*)(nw + c) * (*(const f32x4*)(modl + (size_t)b * 6144 + sc_off + c) + 1.0f); shv[q] = *(const f32x4*)(modl + (size_t)b * 6144 + sh_off + c); } }
        if (COMBINE) {
            Route r[RB];
#pragma unroll
            for (int i = 0; i < RB; ++i) { r[i] = rprev[row0 + i];
                int o0 = 0, o1 = 0; const int e0 = r[i].p0 >> 24, e1 = r[i].p1 >> 24;
#pragma unroll
                for (int e = 0; e < 8; ++e) { o0 = (e == e0) ? coff[e] : o0; o1 = (e == e1) ? coff[e] : o1; }
                r[i].p0 = o0 + (r[i].p0 & 0xffffff); r[i].p1 = o1 + (r[i].p1 & 0xffffff); }
            u32x4 f0[RB][2], f1[RB][2];
#pragma unroll
            for (int i = 0; i < RB; ++i)
#pragma unroll
                for (int j2 = 0; j2 < 2; ++j2) { const int c = 8 * C.lane + 512 * j2; f0[i][j2] = *(const u32x4*)(FS + (size_t)r[i].p0 * D + c); f1[i][j2] = *(const u32x4*)(FS + (size_t)r[i].p1 * D + c); }
#pragma unroll
            for (int j2 = 0; j2 < 2; ++j2) { const int c = 8 * C.lane + 512 * j2;
                const f32x4 ga = *(const f32x4*)(g2prev + (size_t)b * 6144 + c), gb = *(const f32x4*)(g2prev + (size_t)b * 6144 + c + 4);
#pragma unroll
                for (int i = 0; i < RB; ++i) { const u32x4 a = f0[i][j2], d = f1[i][j2]; const float g0 = r[i].g0, g1 = r[i].g1; f32x4 fa, fb;
                    fa[0] = g0 * bflo(a.x) + g1 * bflo(d.x); fa[1] = g0 * bfhi(a.x) + g1 * bfhi(d.x); fa[2] = g0 * bflo(a.y) + g1 * bflo(d.y); fa[3] = g0 * bfhi(a.y) + g1 * bfhi(d.y);
                    fb[0] = g0 * bflo(a.z) + g1 * bflo(d.z); fb[1] = g0 * bfhi(a.z) + g1 * bfhi(d.z); fb[2] = g0 * bflo(a.w) + g1 * bflo(d.w); fb[3] = g0 * bfhi(a.w) + g1 * bfhi(d.w);
                    v[i][2 * j2] = v[i][2 * j2] + ga * fa; v[i][2 * j2 + 1] = v[i][2 * j2 + 1] + gb * fb;
                    if (OUTF32) { *(f32x4*)((float*)xdst + (size_t)(row0 + i) * D + c) = v[i][2 * j2]; *(f32x4*)((float*)xdst + (size_t)(row0 + i) * D + c + 4) = v[i][2 * j2 + 1]; }
                    else { const u32x4 o = pack8f(v[i][2 * j2], v[i][2 * j2 + 1]); *(u32x4*)((bf16_t*)xdst + (size_t)(row0 + i) * D + c) = o;
                        if (NORM) { v[i][2 * j2] = (f32x4){bflo(o.x), bfhi(o.x), bflo(o.y), bfhi(o.y)}; v[i][2 * j2 + 1] = (f32x4){bflo(o.z), bfhi(o.z), bflo(o.w), bfhi(o.w)}; } } } }
        }
        if (NORM) {
            float rs[RB];
#pragma unroll
            for (int i = 0; i < RB; ++i) { float ss = 0.f;
#pragma unroll
                for (int q = 0; q < 4; ++q) ss += (v[i][q][0] * v[i][q][0] + v[i][q][1] * v[i][q][1]) + (v[i][q][2] * v[i][q][2] + v[i][q][3] * v[i][q][3]);
                ss = wave_sum(ss); rs[i] = 1.0f / sqrtf(ss * (1.0f / D) + 1e-6f); }
            float lg[RB][8]; u32x4 hpk[RB][2];
            const int Lr = ROUTER ? opv2_(C.lane) : 0;
            if (ROUTER) {
#pragma unroll
                for (int i = 0; i < RB; ++i)
#pragma unroll
                    for (int e = 0; e < 8; ++e) lg[i][e] = 0.f; }
#pragma unroll
            for (int j2 = 0; j2 < 2; ++j2) { const int c = 8 * C.lane + 512 * j2;
                f32x4 hv[RB][2];
#pragma unroll
                for (int i = 0; i < RB; ++i) { hv[i][0] = (v[i][2 * j2] * rs[i]) * gsc[2 * j2] + shv[2 * j2]; hv[i][1] = (v[i][2 * j2 + 1] * rs[i]) * gsc[2 * j2 + 1] + shv[2 * j2 + 1];
                    const u32x4 o = pack8f(hv[i][0], hv[i][1]);
                    if (ROUTER) hpk[i][j2] = o; else *(u32x4*)(H + (size_t)(row0 + i) * D + c) = o; }
                if (ROUTER) {
#pragma unroll
                    for (int q = 0; q < 8; ++q) { const f32x4 r0 = RW0[(j2 * 8 + q) * 64 + Lr], r1 = RW1[(j2 * 8 + q) * 64 + Lr];
#pragma unroll
                        for (int i = 0; i < RB; ++i) { const float x = hv[i][q >> 2][q & 3];
                            lg[i][0] += x * r0[0]; lg[i][1] += x * r0[1]; lg[i][2] += x * r0[2]; lg[i][3] += x * r0[3];
                            lg[i][4] += x * r1[0]; lg[i][5] += x * r1[1]; lg[i][6] += x * r1[2]; lg[i][7] += x * r1[3]; } } }
            }
            if (ROUTER) {
#pragma unroll
                for (int i = 0; i < RB; ++i) { const int row = row0 + i;
#pragma unroll
                    for (int e = 0; e < 8; ++e) lg[i][e] = wave_sum(lg[i][e]);
                    int e0 = 0; float v0 = lg[i][0];
#pragma unroll
                    for (int e = 1; e < 8; ++e) if (lg[i][e] > v0) { v0 = lg[i][e]; e0 = e; }
                    int e1 = -1; float v1 = -3.0e38f;
#pragma unroll
                    for (int e = 0; e < 8; ++e) if (e != e0 && lg[i][e] > v1) { v1 = lg[i][e]; e1 = e; }
                    unsigned s0 = 0u, s1 = 0u;
                    if (C.lane == 0) {
                        const float g0 = 1.0f / (1.0f + __expf(v1 - v0));
                        s0 = __hip_atomic_fetch_add(cnt + 64 * e0, 1u, __ATOMIC_RELAXED, __HIP_MEMORY_SCOPE_AGENT);
                        s1 = __hip_atomic_fetch_add(cnt + 64 * e1, 1u, __ATOMIC_RELAXED, __HIP_MEMORY_SCOPE_AGENT);
                        Route r; r.p0 = (e0 << 24) | (int)s0; r.p1 = (e1 << 24) | (int)s1; r.g0 = g0; r.g1 = 1.0f - g0;
                        rout[row] = r;
                    }
                    s0 = (unsigned)__builtin_amdgcn_readfirstlane((int)s0); s1 = (unsigned)__builtin_amdgcn_readfirstlane((int)s1);
                    bf16_t* d0 = HSx + ((size_t)e0 * M + s0) * D + 8 * C.lane; bf16_t* d1 = HSx + ((size_t)e1 * M + s1) * D + 8 * C.lane;
#pragma unroll
                    for (int j2 = 0; j2 < 2; ++j2) { *(u32x4*)(d0 + 512 * j2) = hpk[i][j2]; *(u32x4*)(d1 + 512 * j2) = hpk[i][j2]; } }
            }
        }
    }
}
DI f32x4 mfma16(bf16x8 a, bf16x8 b, f32x4 c) { return __builtin_amdgcn_mfma_f32_16x16x32_bf16(a, b, c, 0, 0, 0); }
DI f32x16 mfma32(bf16x8 a, bf16x8 b, f32x16 c) { return __builtin_amdgcn_mfma_f32_32x32x16_bf16(a, b, c, 0, 0, 0); }
DI bf16x8 pack8(f32x4 lo, f32x4 hi) { u32x4 p; p.x = pk2(lo[0], lo[1]); p.y = pk2(lo[2], lo[3]); p.z = pk2(hi[0], hi[1]); p.w = pk2(hi[2], hi[3]); return __builtin_bit_cast(bf16x8, p); }
DI bf16x8 join8(s16x4 lo, s16x4 hi) { return __builtin_shufflevector(lo, hi, 0, 1, 2, 3, 4, 5, 6, 7); }

DI int opv_(int x) { asm volatile("" : "+v"(x)); return x; }
DI void gdn_a_phase(const Ctx& C, int ie) {
    ConvSt cv; cv_init(cv, kargs()->cv_lo[ie], kargs()->cv_hi[ie], C.bid * NWAVES + C.wave);
    const int cvs = C.G * NWAVES;
#define GA_BAR() do { CV_STEP(cv, L.lane, cvs); asm volatile("s_waitcnt lgkmcnt(0)" ::: "memory"); __builtin_amdgcn_s_barrier(); asm volatile("" ::: "memory"); } while (0)
    if (C.bid < 1024) {
    const int h = (C.bid >> 6) & 3;
    LAS float* mm = (LAS float*)(C.lds); LAS unsigned char* vb = C.lds + 17408; LAS unsigned char* uwt = C.lds; LAS float* solL = (LAS float*)(C.lds + 36864);
    LAS unsigned char* raw = C.lds + 36864;
    LAS unsigned char* qb = C.lds + 102400; LAS unsigned char* kb = C.lds + 119808;
    LAS float* beta = (LAS float*)(C.lds + 137216); LAS float* gc = (LAS float*)(C.lds + 137472); LAS float* eg = (LAS float*)(C.lds + 137728);
    LAS unsigned char* qkl = C.lds + 137984;
    const bf16_t* PROJ = (const bf16_t*)(C.ws + WS_PROJ);
    const float* convw = C.in[C.zero + I_ECONV] + (size_t)ie * 4 * 1536;
    const float dtb = C.in[C.zero + I_EDTB][ie * 4 + h], nalog = -expf(C.in[C.zero + I_EALOG][ie * 4 + h]);
    u32x4 rv[7]; float abb = 0.f, aba = 0.f;
#define GA_LOAD(un, TID, LANE) do { const int b_ = (un) >> 8, n_ = (un) & 63; \
        _Pragma("unroll") for (int i = 0; i < 7; ++i) { const int p = (TID) + 512 * i; rv[i] = (u32x4){0u, 0u, 0u, 0u}; \
            if (p < 67 * 48) { const int rr = p / 48, c = p - rr * 48, which = c >> 4, pc = c & 15, pos = n_ * 64 + rr - 3; \
                if (pos >= 0) rv[i] = *(const u32x4*)(PROJ + (size_t)(b_ * SEQ + pos) * EVEN_INP + which * 512 + h * 128 + pc * 8); } } \
        if (C.wave == 0) { const float* AB_ = (const float*)(C.ws + WS_AB) + (size_t)(b_ * SEQ + n_ * 64 + (LANE)) * 8; abb = AB_[h]; aba = AB_[4 + h]; } } while (0)
    GA_LOAD(C.bid, C.tid, C.lane);
#pragma unroll 1
    for (int unit = C.bid; unit < 1024; unit += C.G) {
    Ctx L; L.tid = opv_(C.tid); L.lane = L.tid & 63;
    float cw[6][4];
#pragma unroll
    for (int ch = 0; ch < 6; ++ch)
#pragma unroll
        for (int j = 0; j < 4; ++j) cw[ch][j] = convw[j * 1536 + (ch >> 1) * 512 + h * 128 + (ch & 1) * 64 + L.lane];
#pragma unroll
    for (int i = 0; i < 7; ++i) { const int p = L.tid + 512 * i; if (p < 67 * 48) { const int rr = p / 48, c = p - rr * 48; *(LAS u32x4*)(raw + rr * 768 + c * 16) = rv[i]; } }
    const float bv = abb, av = aba + dtb;
    GA_BAR();
    {
        float w0[6], w1[6], w2[6];
#pragma unroll
        for (int ch = 0; ch < 6; ++ch) { const LAS unsigned char* rp = raw + (8 * C.wave) * 768 + ((ch >> 1) * 128 + (ch & 1) * 64 + L.lane) * 2;
            w0[ch] = bf2f(*(const LAS bf16_t*)(rp)); w1[ch] = bf2f(*(const LAS bf16_t*)(rp + 768)); w2[ch] = bf2f(*(const LAS bf16_t*)(rp + 1536)); }
#pragma unroll
        for (int rr = 0; rr < 8; ++rr) { const int t = 8 * C.wave + rr; float o[6];
#pragma unroll
            for (int ch = 0; ch < 6; ++ch) { const float x3 = bf2f(*(const LAS bf16_t*)(raw + (t + 3) * 768 + ((ch >> 1) * 128 + (ch & 1) * 64 + L.lane) * 2));
                const float a = cw[ch][0] * w0[ch] + cw[ch][1] * w1[ch] + cw[ch][2] * w2[ch] + cw[ch][3] * x3;
                w0[ch] = w1[ch]; w1[ch] = w2[ch]; w2[ch] = x3; o[ch] = a / (1.0f + __expf(-a)); }
            const float sq = wave_sum(o[0] * o[0] + o[1] * o[1]), sk = wave_sum(o[2] * o[2] + o[3] * o[3]);
            const float rq = (1.0f / sqrtf(sq + 1e-6f)) * 0.08838834764831845f, rk = 1.0f / sqrtf(sk + 1e-6f);
            *(LAS bf16_t*)(qb + t * 272 + L.lane * 2) = f2bf(o[0] * rq); *(LAS bf16_t*)(qb + t * 272 + (64 + L.lane) * 2) = f2bf(o[1] * rq);
            *(LAS bf16_t*)(kb + t * 272 + L.lane * 2) = f2bf(o[2] * rk); *(LAS bf16_t*)(kb + t * 272 + (64 + L.lane) * 2) = f2bf(o[3] * rk);
            *(LAS bf16_t*)(vb + t * 272 + L.lane * 2) = f2bf(o[4]); *(LAS bf16_t*)(vb + t * 272 + (64 + L.lane) * 2) = f2bf(o[5]); }
    }
    if (C.wave == 0) {
        const float sp = (av > 20.f) ? av : log1pf(expf(av));
        float g = nalog * sp;
#pragma unroll
        for (int o = 1; o < 64; o <<= 1) { const float u = __shfl_up(g, o); if (L.lane >= o) g += u; }
        beta[L.lane] = 1.0f / (1.0f + expf(-bv)); gc[L.lane] = g; eg[L.lane] = expf(g);
    }
    GA_BAR();
    if (unit + C.G < 1024) GA_LOAD(unit + C.G, L.tid, L.lane);
    {
        const int ti = C.wave >> 1, r16 = L.lane & 15, q4 = L.lane >> 4;
#pragma unroll
        for (int tt = 0; tt < 2; ++tt) { const int tj = 2 * (C.wave & 1) + tt;
            f32x4 akk = {0.f, 0.f, 0.f, 0.f}, aqk = {0.f, 0.f, 0.f, 0.f};
#pragma unroll
            for (int ks = 0; ks < 4; ++ks) {
                const bf16x8 ak = *(const LAS bf16x8*)(kb + (16 * ti + r16) * 272 + ks * 64 + q4 * 16);
                const bf16x8 aq = *(const LAS bf16x8*)(qb + (16 * ti + r16) * 272 + ks * 64 + q4 * 16);
                const bf16x8 bk = *(const LAS bf16x8*)(kb + (16 * tj + r16) * 272 + ks * 64 + q4 * 16);
                akk = mfma16(ak, bk, akk); aqk = mfma16(aq, bk, aqk); }
            const int j = 16 * tj + r16; const float gj = gc[j];
#pragma unroll
            for (int rg = 0; rg < 4; ++rg) { const int i = 16 * ti + 4 * q4 + rg; const float dec = (i >= j) ? __expf(gc[i] - gj) : 0.f;
                mm[i * 68 + j] = (i > j) ? beta[i] * akk[rg] * dec : 0.f;
                *(LAS bf16_t*)(qkl + i * 144 + j * 2) = f2bf(aqk[rg] * dec); }
        }
    }
    GA_BAR();
    LAS float* Tl = (LAS float*)(C.lds + 34816);
    if (L.tid < 64) {
        const int Bq = L.tid >> 4, j = L.tid & 15; float tcol[16];
#pragma unroll
        for (int i = 0; i < 16; ++i) { float a = (i == j) ? 1.0f : 0.0f;
#pragma unroll
            for (int q = 0; q < (i + 3) / 4; ++q) { const f32x4 mv = *(const LAS f32x4*)(mm + (16 * Bq + i) * 68 + 16 * Bq + 4 * q);
#pragma unroll
                for (int jj = 0; jj < 4; ++jj) if (4 * q + jj < i) a -= mv[jj] * tcol[4 * q + jj]; }
            tcol[i] = a; Tl[(Bq * 16 + i) * 16 + j] = a; }
    } else if (L.tid >= 256) {
        const int t2 = L.tid - 256;
        bf16_t* QG = (bf16_t*)(C.ws + WS_GQG) + (size_t)unit * 8192; bf16_t* QKM = (bf16_t*)(C.ws + WS_GQK) + (size_t)unit * 4096;
        for (int idx = t2; idx < 64 * 128; idx += 256) { const int t = idx >> 7, d = idx & 127;
            QG[idx] = f2bf(bf2f(*(const LAS bf16_t*)(qb + t * 272 + d * 2)) * eg[t]); }
#pragma unroll
        for (int i = 0; i < 2; ++i) { const int p = t2 + 256 * i; *(u32x4*)(QKM + p * 8) = *(const LAS u32x4*)(qkl + (p >> 3) * 144 + (p & 7) * 16); }
        if (t2 == 0) ((float*)(C.ws + WS_GL))[unit] = expf(gc[63]);
    }
    GA_BAR();
    {
        const int r16 = L.lane & 15, q4 = L.lane >> 4;
        float tf[4][4];
#pragma unroll
        for (int Bq = 0; Bq < 4; ++Bq)
#pragma unroll
            for (int ks = 0; ks < 4; ++ks) tf[Bq][ks] = Tl[(Bq * 16 + r16) * 16 + 4 * ks + q4];
        GA_BAR();
        bf16_t* Ug = (bf16_t*)(C.ws + WS_GU) + (size_t)unit * 8192; bf16_t* Wg = (bf16_t*)(C.ws + WS_GWN) + (size_t)unit * 8192;
#pragma unroll 1
        for (int cc = 0; cc < 2; ++cc) {
            const int c = 32 * C.wave + 16 * cc + r16;
#pragma unroll
            for (int Bq = 0; Bq < 4; ++Bq) {
                f32x4 acc;
#pragma unroll
                for (int rg = 0; rg < 4; ++rg) { const int i = 16 * Bq + 4 * q4 + rg;
                    acc[rg] = (c < 128) ? bf2f(*(const LAS bf16_t*)(vb + i * 272 + c * 2)) * beta[i] : bf2f(*(const LAS bf16_t*)(kb + i * 272 + (c - 128) * 2)) * (beta[i] * eg[i]); }
#pragma unroll
                for (int ks = 0; ks < 4 * Bq; ++ks)
                    acc = __builtin_amdgcn_mfma_f32_16x16x4f32(-mm[(16 * Bq + r16) * 68 + 4 * ks + q4], solL[(4 * ks + q4) * 256 + 32 * C.wave + 16 * cc + r16], acc, 0, 0, 0);
#pragma unroll
                for (int rg = 0; rg < 4; ++rg) solL[(16 * Bq + 4 * q4 + rg) * 256 + c] = acc[rg];
                f32x4 sol = {0.f, 0.f, 0.f, 0.f};
#pragma unroll
                for (int ks = 0; ks < 4; ++ks) sol = __builtin_amdgcn_mfma_f32_16x16x4f32(tf[Bq][ks], solL[(16 * Bq + 4 * ks + q4) * 256 + c], sol, 0, 0, 0);
#pragma unroll
                for (int rg = 0; rg < 4; ++rg) { const int i = 16 * Bq + 4 * q4 + rg; solL[i * 256 + c] = sol[rg];
                    if (c < 128) Ug[(c >> 4) * 1024 + i * 16 + (c & 15)] = f2bf(sol[rg]); else Wg[i * 128 + (c - 128)] = f2bf(-sol[rg]); }
            }
        }
    }
    GA_BAR();
    if (L.tid < 256) { const int c = L.tid; const float sg = (c < 128) ? 1.0f : -1.0f;
#pragma unroll
        for (int t8 = 0; t8 < 8; ++t8) { u32x4 o;
            o.x = pk2(sg * solL[(8 * t8 + 0) * 256 + c], sg * solL[(8 * t8 + 1) * 256 + c]); o.y = pk2(sg * solL[(8 * t8 + 2) * 256 + c], sg * solL[(8 * t8 + 3) * 256 + c]);
            o.z = pk2(sg * solL[(8 * t8 + 4) * 256 + c], sg * solL[(8 * t8 + 5) * 256 + c]); o.w = pk2(sg * solL[(8 * t8 + 6) * 256 + c], sg * solL[(8 * t8 + 7) * 256 + c]);
            *(LAS u32x4*)(uwt + c * 144 + t8 * 16) = o; } }
    GA_BAR();
    {
        const int r16 = L.lane & 15, q4 = L.lane >> 4; const float gl = gc[63];
        bf16x8 kf[8][2];
#pragma unroll
        for (int ks = 0; ks < 2; ++ks) { float dk[8];
#pragma unroll
            for (int j = 0; j < 8; ++j) dk[j] = __expf(gl - gc[32 * ks + 8 * q4 + j]);
#pragma unroll
            for (int Td = 0; Td < 8; ++Td) { float x[8];
#pragma unroll
                for (int j = 0; j < 8; ++j) x[j] = bf2f(*(const LAS bf16_t*)(kb + (32 * ks + 8 * q4 + j) * 272 + (16 * Td + r16) * 2)) * dk[j];
                u32x4 p; p.x = pk2(x[0], x[1]); p.y = pk2(x[2], x[3]); p.z = pk2(x[4], x[5]); p.w = pk2(x[6], x[7]); kf[Td][ks] = __builtin_bit_cast(bf16x8, p); } }
        const bf16x8 wa0 = *(const LAS bf16x8*)(uwt + (128 + 16 * C.wave + r16) * 144 + q4 * 16), wa1 = *(const LAS bf16x8*)(uwt + (128 + 16 * C.wave + r16) * 144 + 64 + q4 * 16);
        const bf16x8 ub0 = *(const LAS bf16x8*)(uwt + (16 * C.wave + r16) * 144 + q4 * 16), ub1 = *(const LAS bf16x8*)(uwt + (16 * C.wave + r16) * 144 + 64 + q4 * 16);
        bf16_t* GA = (bf16_t*)(C.ws + WS_GA) + (size_t)unit * 16384; bf16_t* GBT = (bf16_t*)(C.ws + WS_GBT) + (size_t)unit * 16384;
#pragma unroll
        for (int Ti = 0; Ti < 8; ++Ti) {
            f32x4 a = {0.f, 0.f, 0.f, 0.f}, bq = {0.f, 0.f, 0.f, 0.f};
            a = mfma16(wa0, kf[Ti][0], a); a = mfma16(wa1, kf[Ti][1], a);
            bq = mfma16(kf[Ti][0], ub0, bq); bq = mfma16(kf[Ti][1], ub1, bq);
            u32x2 oa; oa.x = pk2(a[0], a[1]); oa.y = pk2(a[2], a[3]);
            *(u32x2*)(GA + (size_t)(16 * Ti + r16) * 128 + 16 * C.wave + 4 * q4) = oa;
            u32x2 ob; ob.x = pk2(bq[0], bq[1]); ob.y = pk2(bq[2], bq[3]);
            *(u32x2*)(GBT + (size_t)(16 * C.wave + r16) * 128 + 16 * Ti + 4 * q4) = ob; }
    }
    GA_BAR();
    }
    }
#undef GA_LOAD
#undef GA_BAR
    { const int ln = C.lane; CV_DRAIN(cv, ln, cvs); }
    __syncthreads();
}

DI void s5_load_u(const Ctx& C, const bf16_t* up, u32x4& u0, u32x4& u1) { u0 = *(const u32x4*)(up + (size_t)C.lane * EVEN_INP); u1 = *(const u32x4*)(up + (size_t)C.lane * EVEN_INP + 8); }
DI void s5_put_u(const Ctx& C, LAS unsigned char* ub, const u32x4 u0, const u32x4 u1) { *(LAS u32x4*)(ub + C.lane * 32) = u0; *(LAS u32x4*)(ub + C.lane * 32 + 16) = u1; }
DI void s5_bfrags(const Ctx& C, const unsigned char* cf, int g, bf16x8 (&bfr)[8]) {
    const int r16 = C.lane & 15, q4 = C.lane >> 4;
#pragma unroll
    for (int Nn = 0; Nn < 8; ++Nn) { const float* src = (const float*)(cf + ((Nn < 4) ? COEF_BBR : COEF_BBI)) + (size_t)(g * 64 + 16 * (Nn & 3) + r16) * 16 + 8 * (q4 & 1);
        const f32x4 x0 = *(const f32x4*)src, x1 = *(const f32x4*)(src + 4); const bf16x8 v = pack8(x0, x1);
        bfr[Nn] = (q4 < 2) ? v : (bf16x8){0, 0, 0, 0, 0, 0, 0, 0}; }
}
DI void s5_bu(const Ctx& C, const LAS unsigned char* ub, int sc, const bf16x8 (&bfr)[8], LAS float* BU) {
    const int r16 = C.lane & 15, q4 = C.lane >> 4;
    const bf16x8 av = *(const LAS bf16x8*)(ub + (16 * sc + r16) * 32 + 16 * (q4 & 1));
    const bf16x8 afr = (q4 < 2) ? av : (bf16x8){0, 0, 0, 0, 0, 0, 0, 0};
#pragma unroll
    for (int Nn = 0; Nn < 8; ++Nn) { const f32x4 a = mfma16(afr, bfr[Nn], (f32x4){0.f, 0.f, 0.f, 0.f});
#pragma unroll
        for (int rg = 0; rg < 4; ++rg) BU[(4 * q4 + rg) * 132 + 16 * Nn + r16] = a[rg]; }
}
DI void s5_local_unit(const Ctx& C, int ie, int uid, LAS unsigned char* wl) {
    const int b = uid >> 9, grp = (uid >> 5) & 15, g = uid & 31, gn = g * 64 + C.lane;
    const unsigned char* cf = C.ws + WS_COEF + (size_t)ie * COEF_BYTES;
    const float ar = ((const float*)(cf + COEF_AR))[gn], ai = ((const float*)(cf + COEF_AI))[gn];
    bf16x8 bfr[8]; s5_bfrags(C, cf, g, bfr);
    LAS float* BU = (LAS float*)(wl + 4096);
    const bf16_t* up = (const bf16_t*)(C.ws + WS_PROJ) + (size_t)(b * SEQ + 256 * grp) * EVEN_INP + 2056 + 16 * g;
    u32x4 u0, u1; s5_load_u(C, up, u0, u1);
    float xr = 0.f, xi = 0.f;
#pragma unroll 1
    for (int ck = 0; ck < 4; ++ck) {
        LAS unsigned char* ub = wl + (ck & 1) * 2048;
        s5_put_u(C, ub, u0, u1);
        if (ck < 3) s5_load_u(C, up + (size_t)(ck + 1) * 64 * EVEN_INP, u0, u1);
#pragma unroll 1
        for (int sc = 0; sc < 4; ++sc) {
            s5_bu(C, ub, sc, bfr, BU);
#pragma unroll
            for (int tt = 0; tt < 16; ++tt) { const float br_ = BU[tt * 132 + C.lane], bi_ = BU[tt * 132 + 64 + C.lane];
                const float nr = ar * xr - ai * xi + br_, ni = ar * xi + ai * xr + bi_; xr = nr; xi = ni; }
        }
    }
    ((f32x2*)(C.ws + WS_S5E))[(size_t)((b * 16 + grp) * 32 + g) * 64 + C.lane] = (f32x2){xr, xi};
    asm volatile("s_waitcnt lgkmcnt(0)" ::: "memory");
}

DI void s5_out_unit(const Ctx& C, int ie, int uid, LAS unsigned char* wl) {
    const int b = uid >> 9, grp = (uid >> 5) & 15, g = uid & 31, gn = g * 64 + C.lane;
    const unsigned char* cf = C.ws + WS_COEF + (size_t)ie * COEF_BYTES;
    const float ar = ((const float*)(cf + COEF_AR))[gn], ai = ((const float*)(cf + COEF_AI))[gn];
    const float a64r = ((const float*)(cf + COEF_A64R))[gn], a64i = ((const float*)(cf + COEF_A64I))[gn];
    bf16x8 bfr[8]; s5_bfrags(C, cf, g, bfr);
    LAS float* BU = (LAS float*)(wl + 4096); LAS unsigned char* Xs = wl + 12544;
    const bf16_t* up = (const bf16_t*)(C.ws + WS_PROJ) + (size_t)(b * SEQ + 256 * grp) * EVEN_INP + 2056 + 16 * g;
    u32x4 u0, u1; s5_load_u(C, up, u0, u1);
    const int r16 = C.lane & 15, q4 = C.lane >> 4;
    bf16x8 cfr[4];
    {   const float* cre = C.in[C.zero + I_ECRE] + (size_t)ie * 32768 + (size_t)g * 1024 + r16 * 64 + 8 * q4; const float* cim = C.in[C.zero + I_ECIM] + (size_t)ie * 32768 + (size_t)g * 1024 + r16 * 64 + 8 * q4;
#pragma unroll
        for (int ks = 0; ks < 2; ++ks) { const f32x4 x0 = *(const f32x4*)(cre + 32 * ks), x1 = *(const f32x4*)(cre + 32 * ks + 4), y0 = *(const f32x4*)(cim + 32 * ks), y1 = *(const f32x4*)(cim + 32 * ks + 4);
            cfr[ks] = pack8(x0, x1); cfr[2 + ks] = pack8(-y0, -y1); } }
    float xr = 0.f, xi = 0.f;
    {   const f32x2* E = (const f32x2*)(C.ws + WS_S5E) + (size_t)(b * 16 * 32 + g) * 64 + C.lane;
        f32x2 e[15];
#pragma unroll
        for (int j = 0; j < 15; ++j) e[j] = (j < grp) ? E[(size_t)j * 32 * 64] : (f32x2){0.f, 0.f};
#pragma unroll
        for (int j = 0; j < 15; ++j) if (j < grp) { const float nr = a64r * xr - a64i * xi + e[j].x, ni = a64r * xi + a64i * xr + e[j].y; xr = nr; xi = ni; } }
    const f32x4 dv = *(const f32x4*)(C.in[C.zero + I_EDSKIP] + (size_t)ie * 512 + 16 * g + 4 * q4);
    bf16_t* GY = (bf16_t*)(C.ws + WS_GY);
#pragma unroll 1
    for (int ck = 0; ck < 4; ++ck) {
        LAS unsigned char* ub = wl + (ck & 1) * 2048;
        s5_put_u(C, ub, u0, u1);
        if (ck < 3) s5_load_u(C, up + (size_t)(ck + 1) * 64 * EVEN_INP, u0, u1);
#pragma unroll 1
        for (int sc = 0; sc < 4; ++sc) {
            s5_bu(C, ub, sc, bfr, BU);
#pragma unroll
            for (int tt = 0; tt < 16; ++tt) { const float br_ = BU[tt * 132 + C.lane], bi_ = BU[tt * 132 + 64 + C.lane];
                const float nr = ar * xr - ai * xi + br_, ni = ar * xi + ai * xr + bi_; xr = nr; xi = ni;
                *(LAS bf16_t*)(Xs + tt * 272 + C.lane * 2) = f2bf(xr); *(LAS bf16_t*)(Xs + tt * 272 + (64 + C.lane) * 2) = f2bf(xi); }
            f32x4 y = {0.f, 0.f, 0.f, 0.f};
#pragma unroll
            for (int ks = 0; ks < 4; ++ks) y = mfma16(cfr[ks], *(const LAS bf16x8*)(Xs + r16 * 272 + ks * 64 + q4 * 16), y);
            const int t = 16 * sc + r16;
            const u32x2 uu = *(const LAS u32x2*)(ub + t * 32 + 8 * q4);
            y = y + dv * (f32x4){bflo(uu.x), bfhi(uu.x), bflo(uu.y), bfhi(uu.y)};
#pragma unroll
            for (int j = 0; j < 4; ++j) y[j] = 0.5f * y[j] * (1.0f + erff(y[j] * 0.70710678118654752f));
            u32x2 o; o.x = pk2(y[0], y[1]); o.y = pk2(y[2], y[3]);
            *(u32x2*)(GY + (size_t)(b * SEQ + 256 * grp + 64 * ck + t) * 512 + 16 * g + 4 * q4) = o;
        }
    }
    asm volatile("s_waitcnt lgkmcnt(0)" ::: "memory");
}

DI void gdn_b_chain(const Ctx& C, int chain) {
    constexpr int BUF = 39168, XSO = 2 * BUF;
    const int bh = chain >> 3, sl = chain & 7;
    const int ub = bh * 64;
    const bf16_t* GA = (const bf16_t*)(C.ws + WS_GA); const bf16_t* GBT = (const bf16_t*)(C.ws + WS_GBT); const float* GL = (const float*)(C.ws + WS_GL);
    bf16_t* GST = (bf16_t*)(C.ws + WS_GST);
    u32x4 r0[5], r1[5], r2[5];
#define GB_LOAD(R, nn) do { const size_t un = (size_t)(ub + (nn)); \
        _Pragma("unroll") for (int i_ = 0; i_ < 4; ++i_) R[i_] = *(const u32x4*)(GA + un * 16384 + (size_t)(C.tid + 512 * i_) * 8); \
        if (C.tid < 256) R[4] = *(const u32x4*)(GBT + un * 16384 + (size_t)sl * 2048 + (size_t)C.tid * 8); } while (0)
#define GB_STORE(R, bufi) do { LAS unsigned char* B_ = C.lds + (bufi) * BUF; \
        _Pragma("unroll") for (int i_ = 0; i_ < 4; ++i_) { const int p = C.tid + 512 * i_; *(LAS u32x4*)(B_ + (p >> 4) * 272 + (p & 15) * 16) = R[i_]; } \
        if (C.tid < 256) *(LAS u32x4*)(B_ + 34816 + (C.tid >> 4) * 272 + (C.tid & 15) * 16) = R[4]; } while (0)
    f32x4 S0 = {0.f, 0.f, 0.f, 0.f}, S1 = S0;
    u32x4 ownp = {0u, 0u, 0u, 0u};
    const int w = C.wave, r16 = C.lane & 15, q4 = C.lane >> 4;
    const float glv = GL[ub + C.lane];
    if (w < 4) *(LAS u32x4*)(C.lds + XSO + w * 1024 + C.lane * 16) = ownp;
#define GB_STEP(n, RL, RS) do { \
        if ((n) + 3 < 64) GB_LOAD(RL, (n) + 3); \
        if (w < 4) { \
            const LAS unsigned char* Bf = C.lds + ((n) & 1) * BUF; \
            const LAS unsigned char* xs = C.lds + XSO + ((n) & 1) * 4096 + C.lane * 16; \
            bf16x8 Sb[4]; \
            _Pragma("unroll") for (int s = 0; s < 4; ++s) Sb[s] = *(const LAS bf16x8*)(xs + s * 1024); \
            bf16_t* stp = GST + (size_t)(ub + (n)) * 16384 + (size_t)(sl * 16 + r16) * 128 + 4 * q4 + 32 * w; \
            *(u32x2*)(stp) = (u32x2){ownp.x, ownp.y}; *(u32x2*)(stp + 16) = (u32x2){ownp.z, ownp.w}; \
            const float gl = __int_as_float(__builtin_amdgcn_readlane(__float_as_int(glv), (n))); \
            bf16x8 af[8]; \
            _Pragma("unroll") for (int h_ = 0; h_ < 2; ++h_) _Pragma("unroll") for (int s = 0; s < 4; ++s) { const LAS unsigned char* p = Bf + (16 * (2 * w + h_) + r16) * 272 + (32 * s + 4 * q4) * 2; \
                af[4 * h_ + s] = join8(*(const LAS s16x4*)p, *(const LAS s16x4*)(p + 32)); } \
            const u32x2 bi0 = *(const LAS u32x2*)(Bf + 34816 + r16 * 272 + (32 * w + 4 * q4) * 2), bi1 = *(const LAS u32x2*)(Bf + 34816 + r16 * 272 + (32 * w + 16 + 4 * q4) * 2); \
            f32x4 a0 = S0 * gl + (f32x4){bflo(bi0.x), bfhi(bi0.x), bflo(bi0.y), bfhi(bi0.y)}, a1 = S1 * gl + (f32x4){bflo(bi1.x), bfhi(bi1.x), bflo(bi1.y), bfhi(bi1.y)}; \
            _Pragma("unroll") for (int s = 0; s < 4; ++s) { a0 = mfma16(af[s], Sb[s], a0); a1 = mfma16(af[4 + s], Sb[s], a1); } \
            S0 = a0; S1 = a1; \
            ownp = __builtin_bit_cast(u32x4, pack8(S0, S1)); \
            *(LAS u32x4*)(C.lds + XSO + (((n) + 1) & 1) * 4096 + w * 1024 + C.lane * 16) = ownp; \
        } \
        if ((n) + 1 < 64) GB_STORE(RS, ((n) + 1) & 1); \
        __syncthreads(); } while (0)
    GB_LOAD(r0, 0); GB_STORE(r0, 0);
    GB_LOAD(r1, 1); GB_LOAD(r2, 2);
    __syncthreads();
#pragma unroll 1
    for (int n0 = 0; n0 < 60; n0 += 6) {
        GB_STEP(n0 + 0, r0, r1); GB_STEP(n0 + 1, r1, r2); GB_STEP(n0 + 2, r2, r0);
        GB_STEP(n0 + 3, r0, r1); GB_STEP(n0 + 4, r1, r2); GB_STEP(n0 + 5, r2, r0);
    }
    GB_STEP(60, r0, r1); GB_STEP(61, r1, r2); GB_STEP(62, r2, r0); GB_STEP(63, r0, r1);
#undef GB_LOAD
#undef GB_STORE
#undef GB_STEP
}

DI void gdn_c_phase(const Ctx& C, int ie) {
    if (C.bid >= 1024) return;
    const int h = (C.bid >> 6) & 3;
    LAS unsigned char* L = C.lds; LAS float* red = (LAS float*)(C.lds + 95232);
    const bf16_t* PROJ = (const bf16_t*)(C.ws + WS_PROJ); bf16_t* CAT = (bf16_t*)(C.ws + WS_CAT);
    u32x4 st[13];
#define GC_LOAD(un, TID) do { const size_t u_ = (size_t)(un); const int b_ = (un) >> 8, n_ = (un) & 63; \
        const bf16_t* GWN = (const bf16_t*)(C.ws + WS_GWN) + u_ * 8192; const bf16_t* GQG = (const bf16_t*)(C.ws + WS_GQG) + u_ * 8192; \
        const bf16_t* GQK = (const bf16_t*)(C.ws + WS_GQK) + u_ * 4096; const bf16_t* GU = (const bf16_t*)(C.ws + WS_GU) + u_ * 8192; const bf16_t* GST = (const bf16_t*)(C.ws + WS_GST) + u_ * 16384; \
        _Pragma("unroll") for (int i = 0; i < 2; ++i) { const int p = (TID) + 512 * i; st[i] = *(const u32x4*)(GWN + (size_t)p * 8); st[2 + i] = *(const u32x4*)(GQG + (size_t)p * 8); st[9 + i] = *(const u32x4*)(GU + (size_t)p * 8); \
            st[11 + i] = *(const u32x4*)(PROJ + (size_t)(b_ * SEQ + n_ * 64 + (p >> 4)) * EVEN_INP + 1536 + h * 128 + (p & 15) * 8); } \
        st[4] = *(const u32x4*)(GQK + (size_t)(TID) * 8); \
        _Pragma("unroll") for (int i = 0; i < 4; ++i) st[5 + i] = *(const u32x4*)(GST + (size_t)((TID) + 512 * i) * 8); } while (0)
    GC_LOAD(C.bid, C.tid);
    const float gw = C.in[C.zero + I_EGNW][(size_t)ie * 128 + C.wave * 16 + (C.lane & 15)];
#pragma unroll 1
    for (int unit = C.bid; unit < 1024; unit += C.G) {
        Ctx Lc; Lc.tid = opv_(C.tid); Lc.lane = Lc.tid & 63;
        const int b = unit >> 8, n = unit & 63;
#pragma unroll
        for (int i = 0; i < 2; ++i) { const int p = Lc.tid + 512 * i; *(LAS u32x4*)(L + (p >> 4) * 272 + (p & 15) * 16) = st[i]; *(LAS u32x4*)(L + 17408 + (p >> 4) * 272 + (p & 15) * 16) = st[2 + i];
            *(LAS u32x4*)(L + 78848 + p * 16) = st[9 + i]; *(LAS u32x4*)(L + 97280 + (p >> 4) * 272 + (p & 15) * 16) = st[11 + i]; }
        *(LAS u32x4*)(L + 34816 + (Lc.tid >> 3) * 144 + (Lc.tid & 7) * 16) = st[4];
#pragma unroll
        for (int i = 0; i < 4; ++i) { const int p = Lc.tid + 512 * i; *(LAS u32x4*)(L + 44032 + (p >> 4) * 272 + (p & 15) * 16) = st[5 + i]; }
        __syncthreads();
        if (unit + C.G < 1024) GC_LOAD(unit + C.G, Lc.tid);
        const int sl = C.wave, r16 = Lc.lane & 15, q4 = Lc.lane >> 4;
        bf16x8 Sb[4];
#pragma unroll
        for (int s = 0; s < 4; ++s) { const LAS unsigned char* p = L + 44032 + (16 * sl + r16) * 272 + (32 * s + 4 * q4) * 2; Sb[s] = join8(*(const LAS s16x4*)p, *(const LAS s16x4*)(p + 32)); }
        f32x4 vn[4], o[4];
#pragma unroll
        for (int T = 0; T < 4; ++T) {
            bf16x8 aw[4], aq[4];
#pragma unroll
            for (int s = 0; s < 4; ++s) { const LAS unsigned char* p = L + (16 * T + r16) * 272 + (32 * s + 4 * q4) * 2;
                aw[s] = join8(*(const LAS s16x4*)p, *(const LAS s16x4*)(p + 32)); aq[s] = join8(*(const LAS s16x4*)(p + 17408), *(const LAS s16x4*)(p + 17408 + 32)); }
#pragma unroll
            for (int rg = 0; rg < 4; ++rg) vn[T][rg] = bf2f(*(const LAS bf16_t*)(L + 78848 + sl * 2048 + (16 * T + 4 * q4 + rg) * 32 + r16 * 2));
            o[T] = (f32x4){0.f, 0.f, 0.f, 0.f};
#pragma unroll
            for (int s = 0; s < 4; ++s) { vn[T] = mfma16(aw[s], Sb[s], vn[T]); o[T] = mfma16(aq[s], Sb[s], o[T]); } }
        bf16x8 Vb[2];
#pragma unroll
        for (int s = 0; s < 2; ++s) Vb[s] = pack8(vn[2 * s], vn[2 * s + 1]);
#pragma unroll
        for (int T = 0; T < 4; ++T)
#pragma unroll
            for (int s = 0; s < 2; ++s) { const LAS unsigned char* p = L + 34816 + (16 * T + r16) * 144 + (32 * s + 4 * q4) * 2;
                o[T] = mfma16(join8(*(const LAS s16x4*)p, *(const LAS s16x4*)(p + 32)), Vb[s], o[T]); }
#pragma unroll
        for (int T = 0; T < 4; ++T)
#pragma unroll
            for (int rg = 0; rg < 4; ++rg) { const float ss = row16_sum(o[T][rg] * o[T][rg]); if (r16 == 0) red[C.wave * 64 + 16 * T + 4 * q4 + rg] = ss; }
        __syncthreads();
#pragma unroll
        for (int T = 0; T < 4; ++T)
#pragma unroll
            for (int rg = 0; rg < 4; ++rg) { const int t = 16 * T + 4 * q4 + rg; float tot = 0.f;
#pragma unroll
                for (int w = 0; w < 8; ++w) tot += red[w * 64 + t];
                const float rs = 1.0f / sqrtf(tot * (1.0f / 128.0f) + 1e-6f);
                const float z = bf2f(*(const LAS bf16_t*)(L + 97280 + t * 272 + (sl * 16 + r16) * 2));
                *(LAS bf16_t*)(L + 114688 + t * 272 + (sl * 16 + r16) * 2) = f2bf(o[T][rg] * rs * gw * silu_f(z)); }
        __syncthreads();
#pragma unroll
        for (int i = 0; i < 2; ++i) { const int p = Lc.tid + 512 * i;
            *(u32x4*)(CAT + (size_t)(b * SEQ + n * 64 + (p >> 4)) * D + h * 128 + (p & 15) * 8) = *(const LAS u32x4*)(L + 114688 + (p >> 4) * 272 + (p & 15) * 16); }
        __syncthreads();
    }
#undef GC_LOAD
}


DI int crow32(int reg, int hh) { return (reg & 3) + 8 * (reg >> 2) + 4 * hh; }
DI void attn_block(const Ctx& C, int io, int b, int h, int jq, float lam, float smax_l2, float post) {
    const int Lt = opv_(C.tid), Ll = Lt & 63;
    constexpr int TB = 34816;
    const bf16_t* QN = (const bf16_t*)(C.ws + WS_QN); const bf16_t* KN = (const bf16_t*)(C.ws + WS_KN); const bf16_t* VT = (const bf16_t*)(C.ws + WS_VT);
    bf16_t* OUT = (bf16_t*)(C.ws + WS_CAT);
    LAS float* Ls = (LAS float*)(C.lds + 139264); LAS float* EX = (LAS float*)(C.lds);
    const int t = C.wave & 1, rg = C.wave >> 1, r = Ll & 31, hh = Ll >> 5;
    const int qrow0 = b * SEQ + 128 * jq + 32 * rg;
    bf16x8 Qf[4];
#pragma unroll
    for (int s = 0; s < 4; ++s) Qf[s] = *(const bf16x8*)(QN + (size_t)(qrow0 + r) * D + h * 128 + t * 64 + 16 * s + 8 * hh);
    f32x16 O[4];
#pragma unroll
    for (int ne = 0; ne < 4; ++ne)
#pragma unroll
        for (int i = 0; i < 16; ++i) O[ne][i] = 0.f;
    float lsum = 0.f;
    const int nkt = 2 * jq + 2;
    const int nact = (rg < 2) ? nkt - 1 : nkt;
    u32x4 sk[2], sv[2];
#define AT_LOAD(kt) do { const size_t krow = (size_t)(b * SEQ + 64 * (kt)); \
        _Pragma("unroll") for (int i_ = 0; i_ < 2; ++i_) { const int p = Lt + 512 * i_; \
            sk[i_] = *(const u32x4*)(KN + (krow + (p >> 4)) * D + h * 128 + (p & 15) * 8); \
            sv[i_] = *(const u32x4*)(VT + (size_t)(h * 128 + (p >> 3)) * M + krow + (p & 7) * 8); } } while (0)
#define AT_STORE(bi) do { LAS unsigned char* B_ = C.lds + (bi) * TB; _Pragma("unroll") for (int i_ = 0; i_ < 2; ++i_) { const int p = Lt + 512 * i_; \
            *(LAS u32x4*)(B_ + (p >> 4) * 272 + (p & 15) * 16) = sk[i_]; \
            *(LAS u32x2*)(B_ + 17408 + (p >> 3) * 136 + (p & 7) * 16) = (u32x2){sv[i_].x, sv[i_].y}; *(LAS u32x2*)(B_ + 17408 + (p >> 3) * 136 + (p & 7) * 16 + 8) = (u32x2){sv[i_].z, sv[i_].w}; } } while (0)
#define AT_QK(Xd, bi) do { const LAS unsigned char* Kb_ = C.lds + (bi) * TB + r * 272 + (t * 64 + 8 * hh) * 2; \
        _Pragma("unroll") for (int kb = 0; kb < 2; ++kb) { bf16x8 kf_[4]; \
            _Pragma("unroll") for (int s = 0; s < 4; ++s) kf_[s] = *(const LAS bf16x8*)(Kb_ + kb * 32 * 272 + s * 32); \
            __builtin_amdgcn_sched_barrier(0); \
            _Pragma("unroll") for (int i = 0; i < 16; ++i) Xd[kb][i] = -smax_l2; \
            _Pragma("unroll") for (int s = 0; s < 4; ++s) Xd[kb] = mfma32(kf_[s], Qf[s], Xd[kb]); } } while (0)
#define AT_EXP(Xk, Pf) do { _Pragma("unroll") for (int i = 0; i < 16; ++i) { const float p = __builtin_amdgcn_exp2f(Xk[i]); Xk[i] = p; lsum += p; } \
        _Pragma("unroll") for (int s = 0; s < 2; ++s) { u32x4 pk; pk.x = pk2(Xk[8 * s], Xk[8 * s + 1]); pk.y = pk2(Xk[8 * s + 2], Xk[8 * s + 3]); \
            pk.z = pk2(Xk[8 * s + 4], Xk[8 * s + 5]); pk.w = pk2(Xk[8 * s + 6], Xk[8 * s + 7]); Pf[s] = __builtin_bit_cast(bf16x8, pk); } } while (0)
#define AT_PV(Vb_, kb, Pf) do { _Pragma("unroll") for (int s = 0; s < 2; ++s) { bf16x8 vf_[4]; \
        _Pragma("unroll") for (int ne = 0; ne < 4; ++ne) { const LAS unsigned char* p = (Vb_) + ne * 32 * 136 + (32 * (kb) + 16 * s) * 2; \
            vf_[ne] = join8(*(const LAS s16x4*)p, *(const LAS s16x4*)(p + 16)); } \
        __builtin_amdgcn_sched_barrier(0); \
        _Pragma("unroll") for (int ne = 0; ne < 4; ++ne) O[ne] = mfma32(Pf[s], vf_[ne], O[ne]); } } while (0)
#define AT_STAGE(kt) do { if ((kt) + 2 < nkt) AT_STORE(((kt) + 2) & 3); if ((kt) + 3 < nkt) AT_LOAD((kt) + 3); } while (0)
    AT_LOAD(0); AT_STORE(0);
    AT_LOAD(1); AT_STORE(1);
    if (nkt > 2) AT_LOAD(2);
    __syncthreads();
    bf16x8 P0[2], P1[2];
#pragma unroll
    for (int s = 0; s < 2; ++s) { P0[s] = (bf16x8){0, 0, 0, 0, 0, 0, 0, 0}; P1[s] = P0[s]; }
    if (C.wave < 4) {
#pragma unroll 1
        for (int kt = 0; kt <= nkt; ++kt) {
            AT_STAGE(kt);
            if (kt < nact) {
                f32x16 X[2];
                const LAS unsigned char* Vp = C.lds + (kt & 3) * TB + 17408 + r * 136 + 8 * hh;
                AT_QK(X, kt & 3);
                AT_EXP(X[0], P0); AT_PV(Vp, 0, P0);
                AT_EXP(X[1], P1); AT_PV(Vp, 1, P1);
            }
            __syncthreads();
        }
    } else {
#pragma unroll 1
        for (int kt = 0; kt <= nkt; ++kt) {
            AT_STAGE(kt);
            f32x16 X[2];
            const bool doqk = kt < nact, dopv = (kt >= 1) && (kt - 1 < nact);
            const LAS unsigned char* Vp = C.lds + ((kt + 3) & 3) * TB + 17408 + r * 136 + 8 * hh;
            if (dopv) { AT_PV(Vp, 0, P0); AT_PV(Vp, 1, P1); }
            if (doqk) { AT_QK(X, kt & 3); AT_EXP(X[0], P0); AT_EXP(X[1], P1); }
            __syncthreads();
        }
    }
#undef AT_STAGE
#undef AT_LOAD
#undef AT_STORE
#undef AT_QK
#undef AT_EXP
#undef AT_PV
    lsum += __shfl_xor(lsum, 32);
    if (Ll < 32) Ls[C.wave * 32 + Ll] = lsum;
    __syncthreads();
    float linv[16];
#pragma unroll
    for (int i = 0; i < 16; ++i) linv[i] = 1.0f / Ls[C.wave * 32 + crow32(i, hh)];
    if (t == 1) {
#pragma unroll
        for (int ne = 0; ne < 4; ++ne)
#pragma unroll
            for (int i = 0; i < 16; ++i) EX[(rg * 32 + crow32(i, hh)) * 132 + 32 * ne + r] = O[ne][i] * linv[i] * lam;
    }
    __syncthreads();
    if (t == 0) {
        float ss[16];
#pragma unroll
        for (int i = 0; i < 16; ++i) ss[i] = 0.f;
#pragma unroll
        for (int ne = 0; ne < 4; ++ne)
#pragma unroll
            for (int i = 0; i < 16; ++i) { const float o = O[ne][i] * linv[i] - EX[(rg * 32 + crow32(i, hh)) * 132 + 32 * ne + r]; O[ne][i] = o; ss[i] += o * o; }
#pragma unroll
        for (int i = 0; i < 16; ++i) { float s = ss[i]; s += __shfl_xor(s, 1); s += __shfl_xor(s, 2); s += __shfl_xor(s, 4); s += __shfl_xor(s, 8); s += __shfl_xor(s, 16);
            ss[i] = (1.0f / sqrtf(s * (1.0f / 128.0f) + 1e-6f)) * post; }
        const float* sw = C.in[C.zero + I_OSUBLN] + (size_t)io * 128;
#pragma unroll
        for (int ne = 0; ne < 4; ++ne) { const float w = sw[32 * ne + r];
#pragma unroll
            for (int i = 0; i < 16; ++i) OUT[(size_t)(qrow0 + crow32(i, hh)) * D + h * 128 + 32 * ne + r] = f2bf(O[ne][i] * ss[i] * w); }
    }
    __syncthreads();
}
DI void attn_phase(const Ctx& C, int io, int layer) {
    const float* lq1 = C.in[C.zero + I_OLQ1] + io * 64; const float* lk1 = C.in[C.zero + I_OLK1] + io * 64; const float* lq2 = C.in[C.zero + I_OLQ2] + io * 64; const float* lk2 = C.in[C.zero + I_OLK2] + io * 64;
    const float s1 = wave_sum(lq1[C.lane] * lk1[C.lane]), s2 = wave_sum(lq2[C.lane] * lk2[C.lane]);
    const float lambda_init = 0.8f - 0.6f * expf(-0.3f * (float)layer);
    const float lam = expf(s1) - expf(s2) + lambda_init;
    const float mq = wave_max(fabsf(C.in[C.zero + I_OQNW][io * 64 + C.lane])), mk = wave_max(fabsf(C.in[C.zero + I_OKNW][io * 64 + C.lane]));
    const float smax_l2 = 8.0f * mq * mk * 1.02f * 1.4426950408889634f;
    for (int up = C.bid; up < 512; up += C.G) {
        const int bh = up >> 4, jp = up & 15;
        attn_block(C, io, bh >> 3, bh & 7, jp, lam, smax_l2, 1.0f - lambda_init);
        attn_block(C, io, bh >> 3, bh & 7, 31 - jp, lam, smax_l2, 1.0f - lambda_init);
    }
}
template <class T> DI T* opq(T* p) { const unsigned long long u = (unsigned long long)p; unsigned lo = (unsigned)u, hi = (unsigned)(u >> 32); asm volatile("" : "+v"(lo), "+v"(hi));
    lo = __builtin_amdgcn_readfirstlane(lo); hi = __builtin_amdgcn_readfirstlane(hi); return (T*)(((unsigned long long)hi << 32) | lo); }
DI int opv(int x) { asm volatile("" : "+v"(x)); return x; }
DI int ops(int x) { asm volatile("" : "+v"(x)); return __builtin_amdgcn_readfirstlane(x); }
#define SITE_CTX() Ctx K; K.lds = C.lds; K.tid = opv(C.tid); K.lane = K.tid & 63; K.wave = __builtin_amdgcn_readfirstlane(K.tid >> 6); K.G = ops(C.G); K.bid = ops(C.bid); K.zero = ops(0); \
    K.out = C.out + K.zero; K.ws = C.ws + K.zero; K.in = C.in; unsigned char* ws = K.ws; const float* const* inp = K.in; float* XS = K.out; float* MOD = (float*)(ws + WS_MOD); bf16_t* XB = (bf16_t*)(ws + WS_XB); (void)XB; bf16_t* Hb = (bf16_t*)(ws + WS_H); (void)inp; (void)XS; (void)MOD; (void)Hb;
#ifndef SITE_MASK
#define SITE_MASK 0xFFFFFFFFu
#endif
#define INS(j, k) ((((SITE_MASK) >> (j)) & 1u) && lo <= (k) && (k) < hi)
#define IN(k) (lo <= (k) && (k) < hi)
#ifndef REPEAT_MASK
#define REPEAT_MASK 0u
#endif
#ifndef REPN
#define REPN 2
#endif
#define NREP(j) ((((REPEAT_MASK) >> (j)) & 1u) ? REPN : 1)
#define SEAM(k) do { if (IN(k) && IN((k) + 1)) xcd_barrier(bar); } while (0)
template <int lp>
DI void layer_pair(const Ctx& C, const XcdBarrier& bar, const int lo, const int hi) {
        const int base = 1 + 17 * lp, le = 2 * lp, lod = 2 * lp + 1;
        if (INS(1, base + 0)) { for (int rep_ = 0; rep_ < NREP(1); ++rep_) { SITE_CTX();
            const float* modE = MOD + (size_t)le * 4 * 6144;
            if (lp == 0) norm_phase<false, true, false, true>(K, inp[K.zero + I_X], nullptr, inp[K.zero + I_NMIX] + (size_t)le * D, modE, 1024, 0, Hb, nullptr, nullptr, nullptr, nullptr, nullptr, nullptr, nullptr, nullptr);
            else norm_phase<true, true, false, false>(K, XB, XB, inp[K.zero + I_NMIX] + (size_t)le * D, modE, 1024, 0, Hb, (const Route*)(ws + WS_ROUTE), (const bf16_t*)(ws + WS_FS), MOD + (size_t)(le - 1) * 4 * 6144 + 5120, (const unsigned*)(ws + WS_CTL + CW_CNT), nullptr, nullptr, nullptr, nullptr);
        } }
        SEAM(base + 0);
        if (INS(2, base + 1)) { for (int rep_ = 0; rep_ < NREP(2); ++rep_) { SITE_CTX();
            pg8::Gemm g{Hb, (const bf16_t*)(ws + WS_WIN + (size_t)lp * SZ_WIN), M, EVEN_INP, D}; pg8::StaticOrder S; S.init(M, EVEN_INP, K.G, K.bid);
            pg8::EpiProj E{(bf16_t*)(ws + WS_PROJ), (float*)(ws + WS_AB)};
            pg8::gemm_phase(K.lds, K.tid, g, S, E);
        } }
        SEAM(base + 1);
#define SITE3_BODY { SITE_CTX(); \
            gdn_a_phase(K, lp); \
            for (int u = K.bid * NWAVES + K.wave; u < 2048; u += K.G * NWAVES) s5_local_unit(K, lp, u, K.lds + K.wave * 16896); }
        if (INS(3, base + 2)) { SITE3_BODY
#if defined(REP3)
            __syncthreads(); SITE3_BODY
#endif
        }
        SEAM(base + 2);
        if (INS(4, base + 3)) { for (int rep_ = 0; rep_ < NREP(4); ++rep_) { SITE_CTX();
            if (K.G > 128) {
                if (K.bid < 128) { gdn_b_chain(K, (((K.bid & 7) * 2 + (K.bid >> 6)) << 3) + ((K.bid >> 3) & 7));
#if defined(REP_GDNB)
                    __syncthreads(); gdn_b_chain(K, K.bid);
#endif
                }
                else { for (int u = (K.bid - 128) * NWAVES + K.wave; u < 2048; u += (K.G - 128) * NWAVES) s5_out_unit(K, lp, u, K.lds + K.wave * 16896);
#if defined(REP_S5OUT)
                    for (int u = (K.bid - 128) * NWAVES + K.wave; u < 2048; u += (K.G - 128) * NWAVES) s5_out_unit(K, lp, u, K.lds + K.wave * 16896);
#endif
                }
            } else {
                for (int ch = K.bid; ch < 128; ch += K.G) gdn_b_chain(K, ch);
                for (int u = K.bid * NWAVES + K.wave; u < 2048; u += K.G * NWAVES) s5_out_unit(K, lp, u, K.lds + K.wave * 16896);
            }
        } }
        SEAM(base + 3);
        if (INS(5, base + 4)) { for (int rep_ = 0; rep_ < NREP(5); ++rep_) { SITE_CTX();
            gdn_c_phase(K, lp);
            pg8::Gemm g{(const bf16_t*)(ws + WS_GY), (const bf16_t*)(ws + WS_GLU + (size_t)lp * SZ_GLU), M, 1024, 512}; pg8::StaticOrder S; S.init(M, 1024, K.G, K.bid);
            pg8::EpiGLU E{(bf16_t*)(ws + WS_CAT), inp[K.zero + I_EGLUB] + (size_t)lp * 1024};
            pg8::gemm_phase(K.lds, K.tid, g, S, E);
        } }
        SEAM(base + 4);
        if (INS(6, base + 5)) { for (int rep_ = 0; rep_ < NREP(6); ++rep_) { SITE_CTX();
            pg8::Gemm g{(const bf16_t*)(ws + WS_CAT), (const bf16_t*)(ws + WS_WOE + (size_t)lp * SZ_SQ), M, D, D}; pg8::StaticOrder S; S.init(M, D, K.G, K.bid);
            if (lp == 0) { pg8::EpiResidT<true> E{inp[K.zero + I_X], XB, MOD + (size_t)le * 4 * 6144 + 2048}; pg8::gemm_phase(K.lds, K.tid, g, S, E); }
            else { pg8::EpiResidT<false> E{XB, XB, MOD + (size_t)le * 4 * 6144 + 2048}; pg8::gemm_phase(K.lds, K.tid, g, S, E); }
        } }
        SEAM(base + 5);
        if (INS(7, base + 6)) { for (int rep_ = 0; rep_ < NREP(7); ++rep_) { SITE_CTX();
            norm_phase<false, true, false, false>(K, XB, nullptr, inp[K.zero + I_NFFN] + (size_t)le * D, MOD + (size_t)le * 4 * 6144, 4096, 3072, Hb, nullptr, nullptr, nullptr, nullptr, nullptr, nullptr, nullptr, nullptr); } }
        SEAM(base + 6);
        if (INS(8, base + 7)) { for (int rep_ = 0; rep_ < NREP(8); ++rep_) { SITE_CTX();
            pg8::Gemm g{Hb, (const bf16_t*)(ws + WS_W13 + (size_t)lp * SZ_W13), M, 2 * FF, D}; pg8::StaticOrder S; S.init(M, 2 * FF, K.G, K.bid);
            pg8::EpiSwiGLU E{(bf16_t*)(ws + WS_ACT), FF};
            pg8::gemm_phase(K.lds, K.tid, g, S, E);
        } }
        SEAM(base + 7);
        if (INS(9, base + 8)) { for (int rep_ = 0; rep_ < NREP(9); ++rep_) { SITE_CTX();
            pg8::Gemm g{(const bf16_t*)(ws + WS_ACT), (const bf16_t*)(ws + WS_W2 + (size_t)lp * SZ_W2), M, D, FF}; pg8::StaticOrder S; S.init(M, D, K.G, K.bid);
            pg8::EpiResidT<false> E{XB, XB, MOD + (size_t)le * 4 * 6144 + 5120};
            pg8::gemm_phase(K.lds, K.tid, g, S, E);
        } }
        SEAM(base + 8);
        if (INS(10, base + 9)) { for (int rep_ = 0; rep_ < NREP(10); ++rep_) { SITE_CTX();
            norm_phase<false, true, false, false>(K, XB, nullptr, inp[K.zero + I_NMIX] + (size_t)lod * D, MOD + (size_t)lod * 4 * 6144, 1024, 0, Hb, nullptr, nullptr, nullptr, nullptr, nullptr, nullptr, nullptr, nullptr); } }
        SEAM(base + 9);
        if (INS(11, base + 10)) { for (int rep_ = 0; rep_ < NREP(11); ++rep_) { SITE_CTX();
            {   pg8::Gemm g{Hb, (const bf16_t*)(ws + WS_WQK + (size_t)lp * SZ_WQK), M, 2048, D}; pg8::StaticOrder S; S.init(M, 2048, K.G, K.bid);
                pg8::EpiQKNorm E{(bf16_t*)(ws + WS_QN), (bf16_t*)(ws + WS_KN), inp[K.zero + I_OQNW] + (size_t)lp * 64, inp[K.zero + I_OKNW] + (size_t)lp * 64};
                pg8::gemm_phase(K.lds, K.tid, g, S, E); }
            {
                pg8::Gemm g{(const bf16_t*)(ws + WS_WV + (size_t)lp * SZ_SQ), Hb, D, M, D}; pg8::StaticOrder S; S.init(D, M, K.G, K.bid);
                pg8::EpiBf16Plain E{(bf16_t*)(ws + WS_VT), M};
                pg8::gemm_phase(K.lds, K.tid, g, S, E); }
        } }
        SEAM(base + 10);
        if (INS(12, base + 11)) { for (int rep_ = 0; rep_ < NREP(12); ++rep_) { SITE_CTX(); attn_phase(K, lp, lod); } }
        SEAM(base + 11);
        if (INS(13, base + 12)) { for (int rep_ = 0; rep_ < NREP(13); ++rep_) { SITE_CTX();
            pg8::Gemm g{(const bf16_t*)(ws + WS_CAT), (const bf16_t*)(ws + WS_WOO + (size_t)lp * SZ_SQ), M, D, D}; pg8::StaticOrder S; S.init(M, D, K.G, K.bid);
            pg8::EpiResidT<false> E{XB, XB, MOD + (size_t)lod * 4 * 6144 + 2048};
            pg8::gemm_phase(K.lds, K.tid, g, S, E);
        } }
        SEAM(base + 12);
        if (INS(14, base + 13)) { for (int rep_ = 0; rep_ < NREP(14); ++rep_) { SITE_CTX();
            norm_phase<false, true, true, false>(K, XB, nullptr, inp[K.zero + I_NFFN] + (size_t)lod * D, MOD + (size_t)lod * 4 * 6144, 4096, 3072, Hb, nullptr, nullptr, nullptr, nullptr,
                                          inp[K.zero + I_OROUTER] + (size_t)lp * D * 8, (unsigned*)(ws + WS_CTL + CW_CNT) + (size_t)lp * 8 * 64, (Route*)(ws + WS_ROUTE) + (size_t)lp * M, (bf16_t*)(ws + WS_HS)); } }
        SEAM(base + 13);
        if (INS(16, base + 15)) { for (int rep_ = 0; rep_ < NREP(16); ++rep_) { SITE_CTX();
            pg8::Gemm g{(const bf16_t*)(ws + WS_HS), (const bf16_t*)(ws + WS_EW13 + (size_t)lp * SZ_EW13), MS, 2 * FF, D};
            pg8::GroupedOrder S; S.init((const unsigned*)(ws + WS_CTL + CW_CNT) + (size_t)lp * 8 * 64, 2 * FF / 256, K.G, K.bid, 1);
            pg8::EpiSwiGLU E{(bf16_t*)(ws + WS_ACTS), FF};
            pg8::gemm_phase(K.lds, K.tid, g, S, E);
        } }
        SEAM(base + 15);
        if (INS(17, base + 16)) { for (int rep_ = 0; rep_ < NREP(17); ++rep_) { SITE_CTX();
            pg8::Gemm g{(const bf16_t*)(ws + WS_ACTS), (const bf16_t*)(ws + WS_EW2 + (size_t)lp * SZ_EW2), MS, D, FF};
            pg8::GroupedOrder S; S.init((const unsigned*)(ws + WS_CTL + CW_CNT) + (size_t)lp * 8 * 64, D / 256, K.G, K.bid, 0);
            pg8::EpiBf16Plain E{(bf16_t*)(ws + WS_FS), D};
            pg8::gemm_phase(K.lds, K.tid, g, S, E);
        } }
        SEAM(base + 16);
    }
__global__ void __launch_bounds__(NTHR, 2) fwd_kernel(Args args) {
    extern __shared__ __attribute__((aligned(16))) unsigned char lds_raw[];
    Ctx C;
    C.lds = (LAS unsigned char*)lds_raw; C.tid = threadIdx.x; C.lane = C.tid & 63; C.wave = __builtin_amdgcn_readfirstlane(C.tid >> 6);
    C.G = gridDim.x; C.bid = blockIdx.x; C.zero = 0; C.in = args.in; C.out = args.out; C.ws = args.ws;
    volatile LAS unsigned* xbw = (volatile LAS unsigned*)(C.lds + LDS_BYTES - 16);
    if (C.tid == 0) { xbw[0] = 0u; xbw[1] = 0u; xbw[2] = 0u; xbw[3] = 0u; }
    __syncthreads();
    XcdBarrier bar; bar.bar = (unsigned*)(C.ws + WS_CTL); bar.x = 0; bar.st = xbw;
    const int lo = args.ph_lo, hi = args.ph_hi;
    if (hi - lo > 1) bar = xcd_barrier_post((unsigned*)(C.ws + WS_CTL), xbw);

    if (INS(0, 0)) { for (int rep_ = 0; rep_ < NREP(0); ++rep_) p0_prologue(C, args); }
    SEAM(0);

    layer_pair<0>(C, bar, lo, hi);
    layer_pair<1>(C, bar, lo, hi);
    if (INS(18, 35)) { for (int rep_ = 0; rep_ < NREP(18); ++rep_) { SITE_CTX();
        norm_phase<true, false, false, false, true>(K, XB, XS, nullptr, nullptr, 0, 0, nullptr, (const Route*)(ws + WS_ROUTE) + M, (const bf16_t*)(ws + WS_FS), MOD + (size_t)3 * 4 * 6144 + 5120, (const unsigned*)(ws + WS_CTL + CW_CNT) + 8 * 64, nullptr, nullptr, nullptr, nullptr); } }
#undef IN
#undef INS
#undef SEAM
}

static void fill_desc(Args& a, void* const* d_in, unsigned char* ws) {
    int nd = 0, item = 0;
    auto add = [&](const float* src, size_t dst_off, int ld, int K, int N, int Npad, int E, size_t src_es, int dst_erows, int map, int mp) {
        TDesc& t = a.td[nd++]; t.src = src; t.dst = (bf16_t*)(ws + dst_off); t.ld = ld; t.K = K; t.N = N; t.nblk = Npad / 32; t.E = E; t.map = map; t.mp = mp; t.item0 = item;
        t.src_es = src_es; t.dst_erows = dst_erows; t.pad_ = 0; item += E * (K / 64) * (Npad / 32);
    };
    for (int i = 0; i < 2; ++i) {
        add((const float*)d_in[I_EWIN] + (size_t)i * D * EVEN_IN, WS_WIN + i * SZ_WIN, EVEN_IN, D, EVEN_IN, EVEN_INP, 1, 0, 0, 0, 0);
        add((const float*)d_in[I_EGLUW] + (size_t)i * 512 * 1024, WS_GLU + i * SZ_GLU, 1024, 512, 1024, 1024, 1, 0, 0, 1, 512);
        add((const float*)d_in[I_EWOUT] + (size_t)i * D * D, WS_WOE + i * SZ_SQ, D, D, D, D, 1, 0, 0, 0, 0);
        add((const float*)d_in[I_EW13] + (size_t)i * D * 2 * FF, WS_W13 + i * SZ_W13, 2 * FF, D, 2 * FF, 2 * FF, 1, 0, 0, 1, FF);
        add((const float*)d_in[I_EW2] + (size_t)i * FF * D, WS_W2 + i * SZ_W2, D, FF, D, D, 1, 0, 0, 0, 0);
        add((const float*)d_in[I_OWQKV] + (size_t)i * D * 3072, WS_WQK + i * SZ_WQK, 3072, D, 2048, 2048, 1, 0, 0, 2, 0);
        add((const float*)d_in[I_OWQKV] + (size_t)i * D * 3072 + 2048, WS_WV + i * SZ_SQ, 3072, D, 1024, 1024, 1, 0, 0, 0, 0);
        add((const float*)d_in[I_OWOUT] + (size_t)i * D * D, WS_WOO + i * SZ_SQ, D, D, D, D, 1, 0, 0, 0, 0);
        add((const float*)d_in[I_OEW13] + (size_t)i * NEXP * D * 2 * FF, WS_EW13 + i * SZ_EW13, 2 * FF, D, 2 * FF, 2 * FF, NEXP, (size_t)D * 2 * FF, 2 * FF, 1, FF);
        add((const float*)d_in[I_OEW2] + (size_t)i * NEXP * FF * D, WS_EW2 + i * SZ_EW2, D, FF, D, D, NEXP, (size_t)FF * D, D, 0, 0);
    }
    a.n_items = item;
    a.n_pro = a.td[5].item0;
    a.cv_lo[0] = a.n_pro; a.cv_hi[0] = a.td[18].item0;
    a.cv_lo[1] = a.td[18].item0; a.cv_hi[1] = item;
}

#ifndef MK_N_LAUNCHES
#define MK_N_LAUNCHES 1
#endif

extern "C" void kernel_launch(void* const* d_in, const int* in_sizes, int n_in, void* d_out, int out_size, void* d_ws, size_t ws_size, hipStream_t stream) {
    static int grid = 0;
    if (grid == 0) {
        if (n_in != N_IN || out_size != M * D || ws_size < WS_END) { fprintf(stderr, "kernel_launch: unexpected problem: n_in %d out %d ws %zu (need %zu)\n", n_in, out_size, ws_size, (size_t)WS_END); grid = -1; return; }
        int dev = 0, cus = 0, per_cu = 0;
        if (hipGetDevice(&dev) != hipSuccess || hipDeviceGetAttribute(&cus, hipDeviceAttributeMultiprocessorCount, dev) != hipSuccess) { grid = -1; return; }
        if (hipFuncSetAttribute((const void*)fwd_kernel, hipFuncAttributeMaxDynamicSharedMemorySize, LDS_BYTES) != hipSuccess) { fprintf(stderr, "kernel_launch: hipFuncSetAttribute failed\n"); grid = -1; return; }
        if (hipOccupancyMaxActiveBlocksPerMultiprocessor(&per_cu, (const void*)fwd_kernel, NTHR, LDS_BYTES) != hipSuccess || per_cu < 1) { fprintf(stderr, "kernel_launch: occupancy query says %d\n", per_cu); }
        (void)hipGetLastError();
        grid = cus;
    }
    if (grid < 0) return;
    (void)hipMemsetAsync((char*)d_ws + WS_CTL, 0, CTL_BYTES, stream);
    Args a; memset(&a, 0, sizeof(a));
    for (int i = 0; i < N_IN; ++i) a.in[i] = (const float*)d_in[i];
    a.out = (float*)d_out; a.ws = (unsigned char*)d_ws;
    fill_desc(a, d_in, (unsigned char*)d_ws);
    if (MK_N_LAUNCHES == 1) {
        a.ph_lo = 0; a.ph_hi = NPH; a.coop = 0;
        hipLaunchKernelGGL(fwd_kernel, dim3(grid), dim3(NTHR), LDS_BYTES, stream, a);
    } else {
        for (int p = 0; p < NPH; ++p) { a.ph_lo = p; a.ph_hi = p + 1; a.coop = 0; hipLaunchKernelGGL(fwd_kernel, dim3(grid), dim3(NTHR), LDS_BYTES, stream, a); }
    }
}
```
